# Optimizing an MI355X kernel written in HIP

```python
import math
import jax, jax.numpy as jnp
from jax import lax
import numpy as np

D_MODEL = 2048
BATCH = 16
SEQ = 256
DEPTH = 2
DEC_BATCH = 4
DEC_SEQ = 1024
PAST_LEN = 256

GRID_W = 64
D_A = D_MODEL // 2
D_B = D_MODEL // 2
HGRN_EXPAND = 128
H_A = D_A // HGRN_EXPAND
DK_A = HGRN_EXPAND
DV_A = D_A // H_A
CHUNK = 32
HY_ORDER = 2
HY_EMB = 33
HY_BANDS = (HY_EMB - 1) // 2
HY_HID = 64
HY_SIN_W = 1.0
D_FF = 5632
N_MOD = 6 * D_MODEL
N_PROJ = 5 * D_A + 3 * D_B + 2 * D_MODEL
PROJ_SPLITS = (D_A, 2 * D_A, 3 * D_A, 4 * D_A, 5 * D_A, 5 * D_A + 3 * D_B, 5 * D_A + 3 * D_B + D_MODEL)
EPS = 1e-6

kernel_name = 'hgrn2_hyena_gated_prefix_diffusion_step'


def _rmsnorm(x, g):
    xf = x.astype(jnp.float32)
    y = xf * lax.rsqrt(jnp.mean(xf * xf, axis=-1, keepdims=True) + EPS)
    return y.astype(x.dtype) * g


def _dwconv_seq(x, w, b):
    L = x.shape[1]
    xp = jnp.pad(x, ((0, 0), (1, 1), (0, 0)))
    return xp[:, :L] * w[0] + xp[:, 1:L + 1] * w[1] + xp[:, 2:] * w[2] + b


def _dwconv_grid(x, w, b):
    bsz, L, C = x.shape
    rows = L // GRID_W
    xg = x.reshape(bsz, rows, GRID_W, C)
    y = lax.conv_general_dilated(xg, w[:, :, None, :], (1, 1), 'SAME',
                                 dimension_numbers=('NHWC', 'HWIO', 'NHWC'),
                                 feature_group_count=C)
    return y.reshape(bsz, L, C) + b


def _chunk_scan(q, k, v, logf, s0):
    bsz, L, H, _ = q.shape
    dv = v.shape[-1]
    n = L // CHUNK

    def to_chunks(t):
        return t.reshape(bsz, n, CHUNK, H, t.shape[-1]).transpose(1, 0, 3, 2, 4)

    tri = jnp.tril(jnp.ones((CHUNK, CHUNK), dtype=bool))[:, :, None]

    def step(s, inp):
        qc, kc, vc, lc = inp
        b = jnp.cumsum(lc, axis=2)
        o_inter = jnp.einsum('bhtd,bhde->bhte', qc * jnp.exp(b), s)
        diff = b[:, :, :, None, :] - b[:, :, None, :, :]
        decay = jnp.exp(jnp.where(tri, diff, -jnp.inf))
        att = jnp.einsum('bhtd,bhsd,bhtsd->bhts', qc, kc, decay)
        o = o_inter + jnp.einsum('bhts,bhse->bhte', att, vc)
        b_last = b[:, :, -1:, :]
        s_new = jnp.exp(b_last[:, :, 0, :])[..., None] * s + jnp.einsum(
            'bhsd,bhse->bhde', kc * jnp.exp(b_last - b), vc)
        return s_new, o

    s_fin, o = lax.scan(step, s0.astype(jnp.float32),
                        (to_chunks(q), to_chunks(k), to_chunks(v), to_chunks(logf)))
    o = o.transpose(1, 0, 3, 2, 4).reshape(bsz, L, H, dv)
    return o, s_fin


def _hgrn_mixer(q_raw, fa_raw, fb_raw, i_raw, g_raw, lb, norm_w, s0):
    bsz, L, _ = q_raw.shape
    f32 = jnp.float32
    q = jax.nn.silu(q_raw.astype(f32)).reshape(bsz, L, H_A, DK_A)
    v = i_raw.astype(f32).reshape(bsz, L, H_A, DV_A)
    o_sum = None
    states = []
    for d, (f_raw, rev) in enumerate(((fa_raw, False), (fb_raw, True))):
        z = f_raw.astype(f32)
        lbd = lb[d].astype(f32)
        logf = jnp.logaddexp(jnp.log(lbd), jnp.log1p(-lbd) + jax.nn.log_sigmoid(z))
        k = (1.0 - lbd) * jax.nn.sigmoid(-z)
        logf = logf.reshape(bsz, L, H_A, DK_A)
        k = k.reshape(bsz, L, H_A, DK_A)
        if rev:
            o_d, s_d = _chunk_scan(q[:, ::-1], k[:, ::-1], v[:, ::-1], logf[:, ::-1], s0[:, d])
            o_d = o_d[:, ::-1]
        else:
            o_d, s_d = _chunk_scan(q, k, v, logf, s0[:, d])
        o_sum = o_d if o_sum is None else o_sum + o_d
        states.append(s_d)
    o = _rmsnorm(o_sum, norm_w.astype(f32)).reshape(bsz, L, D_A)
    o = o * jax.nn.silu(g_raw.astype(f32))
    return o.astype(q_raw.dtype), jnp.stack(states, axis=1)


def _hyena_filters(L, w1, b1, w2, b2, w3, decay):
    f32 = jnp.float32
    t = jnp.arange(L, dtype=f32)
    t01 = t / max(L - 1, 1)
    bands = jnp.linspace(1e-4, HY_BANDS - 1, HY_BANDS, dtype=f32)
    ang = (2.0 * math.pi / L) * t[:, None] * bands[None, :]
    feats = jnp.concatenate([t01[:, None], jnp.cos(ang), -jnp.sin(ang)], axis=-1)
    h = jnp.sin(HY_SIN_W * (feats @ w1.astype(f32) + b1.astype(f32)))
    h = jnp.sin(HY_SIN_W * (h @ w2.astype(f32) + b2.astype(f32)))
    h = (h @ w3.astype(f32)).reshape(L, HY_ORDER, 2, D_B)
    window = jnp.exp(-t01[:, None, None] * jnp.abs(decay.astype(f32))[None])
    h = h * window[:, :, None, :]
    hf, hb = h[:, :, 0], h[:, :, 1]
    zero = jnp.zeros_like(hf[:1])
    k2 = jnp.concatenate([hf[:1] + hb[:1], hf[1:], zero, hb[1:][::-1]], axis=0)
    k2 = k2 / (jnp.sum(jnp.abs(k2), axis=0, keepdims=True) + EPS)
    return jnp.fft.rfft(k2, axis=0)


def _fftconv(z, kf, bias):
    L = z.shape[1]
    zf = jnp.fft.rfft(z, n=2 * L, axis=1)
    y = jnp.fft.irfft(zf * kf[None], n=2 * L, axis=1)[:, :L]
    return y + z * bias


def _hyena_mixer(u, conv_w, conv_b, w1, b1, w2, b2, w3, decay, bias):
    L = u.shape[1]
    uc = _dwconv_seq(u, conv_w, conv_b).astype(jnp.float32)
    v, x1, x2 = jnp.split(uc, 3, axis=-1)
    kf = _hyena_filters(L, w1, b1, w2, b2, w3, decay)
    bias = bias.astype(jnp.float32)
    z = x1 * _fftconv(v, kf[:, 0], bias[0])
    y = x2 * _fftconv(z, kf[:, 1], bias[1])
    return y.astype(u.dtype)


def _layer(x, cond, s0, lb, grid, lp):
    mod = jax.nn.silu(cond) @ lp['w_mod'] + lp['b_mod']
    sh1, sc1, gt1, sh2, sc2, gt2 = [m[:, None, :] for m in jnp.split(mod, 6, axis=-1)]
    h = _rmsnorm(x, lp['g_pre_mix']) * (1.0 + sc1) + sh1
    proj = h @ lp['w_in']
    q_raw, fa_raw, fb_raw, i_raw, g_raw, hy_in, gate_a, gate_b = jnp.split(proj, PROJ_SPLITS, axis=-1)
    o_a, s_fin = _hgrn_mixer(q_raw, fa_raw, fb_raw, i_raw, g_raw, lb, lp['hgrn_norm'], s0)
    o_b = _hyena_mixer(hy_in, lp['hy_conv_w'], lp['hy_conv_b'], lp['hy_w1'], lp['hy_b1'],
                       lp['hy_w2'], lp['hy_b2'], lp['hy_w3'], lp['hy_decay'], lp['hy_bias'])
    merged = (jax.nn.sigmoid(gate_a) * (o_a @ lp['w_branch_a'])
              + jax.nn.sigmoid(gate_b) * (o_b @ lp['w_branch_b']))
    x = x + gt1 * _rmsnorm(merged @ lp['w_out'], lp['g_post_mix'])
    h = _rmsnorm(x, lp['g_pre_ffn']) * (1.0 + sc2) + sh2
    u = h @ lp['ffn_w_up']
    if grid:
        u = _dwconv_grid(u, lp['ffn_conv_w'], lp['ffn_conv_b'])
    else:
        u = _dwconv_seq(u, lp['ffn_conv_w'][1], lp['ffn_conv_b'])
    a, vv = jnp.split(u, 2, axis=-1)
    x = x + gt2 * _rmsnorm((jax.nn.silu(a) * vv) @ lp['ffn_w_down'], lp['g_post_ffn'])
    return x, s_fin


def setup_inputs(seed: int = 0) -> dict:
    key = jax.random.key(seed)
    ks = jax.random.split(key, 32)
    f32 = jnp.float32
    D = D_MODEL

    def nrm(k, shape, scale):
        return jax.random.normal(k, shape, f32) * scale

    decay_base = jnp.asarray(np.linspace(math.log(1e2) / 1.5, math.log(1e2) / 0.3, D_B), dtype=f32)
    return {
        'x_prompt': nrm(ks[0], (BATCH, SEQ, D), 1.0),
        'x_sample': nrm(ks[1], (DEC_BATCH, DEC_SEQ, D), 1.0),
        'state_hgrn': nrm(ks[2], (DEC_BATCH, DEPTH, 2, H_A, DK_A, DV_A), 0.5),
        'c': nrm(ks[3], (DEC_BATCH, D), 1.0),
        'c_ctx': nrm(ks[4], (D,), 1.0),
        'w_mod': nrm(ks[5], (DEPTH, D, N_MOD), 0.5 * D ** -0.5),
        'b_mod': nrm(ks[6], (DEPTH, N_MOD), 0.01),
        'g_pre_mix': 1.0 + nrm(ks[7], (DEPTH, D), 0.05),
        'g_post_mix': 1.0 + nrm(ks[8], (DEPTH, D), 0.05),
        'g_pre_ffn': 1.0 + nrm(ks[9], (DEPTH, D), 0.05),
        'g_post_ffn': 1.0 + nrm(ks[10], (DEPTH, D), 0.05),
        'w_in': nrm(ks[11], (DEPTH, D, N_PROJ), D ** -0.5),
        'hgrn_lower_bounds': nrm(ks[12], (DEPTH, 2, D_A), 0.1),
        'hgrn_norm': 1.0 + nrm(ks[13], (DEPTH, DV_A), 0.05),
        'hy_conv_w': nrm(ks[14], (DEPTH, 3, 3 * D_B), 0.5),
        'hy_conv_b': nrm(ks[15], (DEPTH, 3 * D_B), 0.01),
        'hy_w1': nrm(ks[16], (DEPTH, HY_EMB, HY_HID), HY_EMB ** -0.5),
        'hy_b1': nrm(ks[17], (DEPTH, HY_HID), 0.1),
        'hy_w2': nrm(ks[18], (DEPTH, HY_HID, HY_HID), HY_HID ** -0.5),
        'hy_b2': nrm(ks[19], (DEPTH, HY_HID), 0.1),
        'hy_w3': nrm(ks[20], (DEPTH, HY_HID, HY_ORDER * 2 * D_B), HY_HID ** -0.5),
        'hy_decay': decay_base * (1.0 + nrm(ks[21], (DEPTH, HY_ORDER, D_B), 0.1)),
        'hy_bias': nrm(ks[22], (DEPTH, HY_ORDER, D_B), 0.5),
        'w_branch_a': nrm(ks[23], (DEPTH, D_A, D), D_A ** -0.5),
        'w_branch_b': nrm(ks[24], (DEPTH, D_B, D), D_B ** -0.5),
        'w_out': nrm(ks[25], (DEPTH, D, D), D ** -0.5),
        'ffn_w_up': nrm(ks[26], (DEPTH, D, 2 * D_FF), D ** -0.5),
        'ffn_conv_w': nrm(ks[27], (DEPTH, 3, 3, 2 * D_FF), 1.0 / 3.0),
        'ffn_conv_b': nrm(ks[28], (DEPTH, 2 * D_FF), 0.01),
        'ffn_w_down': nrm(ks[29], (DEPTH, D_FF, D), D_FF ** -0.5),
    }


def reference(x_prompt, x_sample, state_hgrn, c, c_ctx, w_mod, b_mod, g_pre_mix, g_post_mix,
              g_pre_ffn, g_post_ffn, w_in, hgrn_lower_bounds, hgrn_norm, hy_conv_w, hy_conv_b,
              hy_w1, hy_b1, hy_w2, hy_b2, hy_w3, hy_decay, hy_bias, w_branch_a, w_branch_b,
              w_out, ffn_w_up, ffn_conv_w, ffn_conv_b, ffn_w_down):
    p_lb = jax.nn.softmax(hgrn_lower_bounds.astype(jnp.float32), axis=0)
    cs = jnp.cumsum(p_lb, axis=0)
    lbs = cs - cs[:1]

    y_prompt = x_prompt
    y_sample = x_sample
    s0_ctx = jnp.zeros((x_prompt.shape[0], 2, H_A, DK_A, DV_A), jnp.float32)
    cond_ctx = c_ctx[None, :]
    new_states = []
    for l in range(DEPTH):
        lp = {
            'w_mod': w_mod[l], 'b_mod': b_mod[l],
            'g_pre_mix': g_pre_mix[l], 'g_post_mix': g_post_mix[l],
            'g_pre_ffn': g_pre_ffn[l], 'g_post_ffn': g_post_ffn[l],
            'w_in': w_in[l], 'hgrn_norm': hgrn_norm[l],
            'hy_conv_w': hy_conv_w[l], 'hy_conv_b': hy_conv_b[l],
            'hy_w1': hy_w1[l], 'hy_b1': hy_b1[l], 'hy_w2': hy_w2[l], 'hy_b2': hy_b2[l],
            'hy_w3': hy_w3[l], 'hy_decay': hy_decay[l], 'hy_bias': hy_bias[l],
            'w_branch_a': w_branch_a[l], 'w_branch_b': w_branch_b[l], 'w_out': w_out[l],
            'ffn_w_up': ffn_w_up[l], 'ffn_conv_w': ffn_conv_w[l], 'ffn_conv_b': ffn_conv_b[l],
            'ffn_w_down': ffn_w_down[l],
        }
        y_prompt, st_ctx = _layer(y_prompt, cond_ctx, s0_ctx, lbs[l], False, lp)
        new_states.append(st_ctx)
        y_sample, _ = _layer(y_sample, c, state_hgrn[:, l], lbs[l], True, lp)
    new_state_hgrn = jnp.stack(new_states, axis=1).astype(x_prompt.dtype)
    return (y_prompt, y_sample, new_state_hgrn)
```

```cpp
#include <hip/hip_runtime.h>
#include <hip/hip_cooperative_groups.h>
#include <cstdio>
#include <cstdint>
namespace cg = cooperative_groups;

#ifndef PER_PHASE_LAUNCH
#define PER_PHASE_LAUNCH 0
#endif

#ifndef DUPMASK
#define DUPMASK 0
#endif
#define LAS __attribute__((address_space(3)))
typedef unsigned short bf16_t;
typedef short bf16x8 __attribute__((ext_vector_type(8)));
typedef float f32x4 __attribute__((ext_vector_type(4)));
typedef unsigned u32x4 __attribute__((ext_vector_type(4)));
typedef unsigned u32x2 __attribute__((ext_vector_type(2)));

constexpr int D = 2048, NTOK = 8192, NCTX = 4096, NPROJ = 12288, DA = 1024, DFF = 5632, NUP = 11264, NMOD = 12288;
constexpr float EPS = 1e-6f;
constexpr int LDS_BYTES = 131072 + 16;
constexpr int NPHASE = 22;

constexpr size_t SZ_WIN = (size_t)NPROJ * D * 2, SZ_WBR = (size_t)D * DA * 2, SZ_WOUT = (size_t)D * D * 2, SZ_WUP = (size_t)NUP * D * 2, SZ_WDN = (size_t)D * DFF * 2;
constexpr size_t WS_WIN = 0;
constexpr size_t WS_WA = WS_WIN + 2 * SZ_WIN;
constexpr size_t WS_WB = WS_WA + 2 * SZ_WBR;
constexpr size_t WS_WOUT = WS_WB + 2 * SZ_WBR;
constexpr size_t WS_WUP = WS_WOUT + 2 * SZ_WOUT;
constexpr size_t WS_WDN = WS_WUP + 2 * SZ_WUP;
constexpr size_t WS_MOD = WS_WDN + 2 * SZ_WDN;
constexpr size_t WS_H2 = WS_MOD + (size_t)2 * 5 * NMOD * 4;
constexpr size_t FILT_L = (size_t)2 * 1024 * 2048 + (size_t)2 * 1024 * 512;
constexpr size_t WS_FILT = WS_H2 + (size_t)2 * 1280 * 64 * 4;
constexpr size_t WS_HB = WS_FILT + 2 * FILT_L * 2;
constexpr size_t WS_OA = WS_HB + (size_t)NTOK * D * 2;
constexpr size_t WS_OB = WS_OA + (size_t)NTOK * DA * 2;
constexpr size_t WS_A = WS_OB + (size_t)NTOK * DA * 2;
constexpr size_t WS_B = WS_A + (size_t)NTOK * NPROJ * 2;
constexpr size_t SZ_HYT = (size_t)3072 * NTOK * 2;
constexpr size_t WS_D = WS_B + SZ_HYT + (size_t)2 * NTOK * DA * 4;
constexpr size_t WS_BAR = WS_D + (size_t)NTOK * D * 4;
constexpr size_t WS_END = WS_BAR + 16384;

struct Params {
    const float* in[30];
    float* out; unsigned char* ws;
    int ph_lo, ph_hi;
};
typedef const __attribute__((address_space(4))) Params* PP;
enum { I_XP = 0, I_XS, I_STATE, I_C, I_CCTX, I_WMOD, I_BMOD, I_GPREMIX, I_GPOSTMIX, I_GPREFFN, I_GPOSTFFN, I_WIN, I_LB, I_HNORM, I_HYCW, I_HYCB,
       I_HYW1, I_HYB1, I_HYW2, I_HYB2, I_HYW3, I_HYDEC, I_HYBIAS, I_WA, I_WB, I_WOUT, I_WUP, I_FCW, I_FCB, I_WDN };

__device__ __forceinline__ float bf2f(unsigned b) { return __uint_as_float(b << 16); }
__device__ __forceinline__ float bflo(unsigned w) { return __uint_as_float(w << 16); }
__device__ __forceinline__ float bfhi(unsigned w) { return __uint_as_float(w & 0xffff0000u); }
__device__ __forceinline__ unsigned pk2(float lo, float hi) { unsigned r; asm("v_cvt_pk_bf16_f32 %0, %1, %2" : "=v"(r) : "v"(lo), "v"(hi)); return r; }
__device__ __forceinline__ bf16_t f2bf(float f) { return (bf16_t)(pk2(f, 0.f) & 0xffffu); }
__device__ __forceinline__ float wave_sum(float v) {
#pragma unroll
    for (int o = 1; o < 64; o <<= 1) v += __shfl_xor(v, o);
    return v;
}
#define LBAR() do { asm volatile("s_waitcnt lgkmcnt(0)" ::: "memory"); __builtin_amdgcn_s_barrier(); asm volatile("" ::: "memory"); } while (0)
__device__ __forceinline__ int TID() { int t = threadIdx.x; asm volatile("" : "+v"(t)); return t; }
__device__ __forceinline__ int BID() { int b = blockIdx.x; asm volatile("" : "+s"(b)); return b; }
__device__ __forceinline__ float sigmoidf_(float z) { return __builtin_amdgcn_rcpf(1.f + __expf(-z)); }
__device__ __forceinline__ float siluf_(float z) { return z * __builtin_amdgcn_rcpf(1.f + __expf(-z)); }

namespace pg8 {
constexpr int BM = 256, BK = 64, HALF = 128, HTB = HALF * BK * 2, STAGE_BYTES = 8 * HTB, NXCD = 8, WGM = 8;
__host__ __device__ __forceinline__ int lds_byte(int r, int c) { const int st = (r >> 4) * 2 + (c >> 5), rr = r & 15, cc = c & 31, ob = rr * 64 + cc * 2; return st * 1024 + (ob ^ (((ob >> 9) & 1) << 5)); }
__host__ __device__ __forceinline__ void stage_rc(int b, int& R, int& C) { const int st = b / 1024, sb = b % 1024, swz = sb ^ (((sb >> 9) & 1) << 5); R = (st >> 1) * 16 + swz / 64; C = (st & 1) * 32 + (swz % 64) / 2; }
__host__ __device__ __forceinline__ int perm32(int rho) { const int n = rho >> 4, i = rho & 15; return 8 * (i >> 2) + 4 * n + (i & 3); }

struct Unit { int pm, pn; };
struct Gemm { const bf16_t* A; const bf16_t* Bt; int M, N, K; };

struct StaticOrder {
    int nM, nN, nwg, G, c, sw_lo, sw_hi;
    __device__ void init(int M, int N, int G_, int c_, int swlo, int swhi) { nM = M / BM; nN = N / BM; nwg = nM * nN; G = G_; c = c_; sw_lo = swlo; sw_hi = swhi; }
    __device__ bool next(int i, Unit& u) const {
        const long L = (long)i * G + c; if (L >= nwg) return false;
        int wgid = (int)L; { const int q = nwg / NXCD, r = nwg % NXCD, xcd = wgid % NXCD, off = wgid / NXCD; wgid = (xcd < r ? xcd * (q + 1) : r * (q + 1) + (xcd - r) * q) + off; }
        const int nig = WGM * nN, gid = wgid / nig, fm = gid * WGM, gsz = (nM - fm) < WGM ? (nM - fm) : WGM;
        u.pm = fm + ((wgid % nig) % gsz); u.pn = (wgid % nig) / gsz; return true;
    }
    __device__ __forceinline__ bool is_sw(const Unit& u) const { return u.pn >= sw_lo && u.pn < sw_hi; }
};

enum { EP_PROJ = 0, EP_BF16 = 1, EP_BRA = 2, EP_BRB = 3, EP_F32 = 4 };
template <int MODE> struct Epi {
    static constexpr bool PERM = (MODE != EP_F32);
    bf16_t* O; int ldc; float* C; const bf16_t* G; const bf16_t* T; bf16_t* HYT;
    __device__ __forceinline__ void operator()(const f32x4 (&acc)[2][2][4][2], const Unit& u, bool sw, int wr, int wc, int fr, int fq) const {
        if constexpr (MODE == EP_F32) {
            const int row0 = u.pm * BM + wr * 64 + fr, col0 = u.pn * BM + wc * 32 + 4 * fq;
#pragma unroll
            for (int ai = 0; ai < 2; ++ai)
#pragma unroll
                for (int m = 0; m < 4; ++m) { float* rowp = C + (size_t)(row0 + ai * HALF + m * 16) * ldc + col0;
#pragma unroll
                    for (int bj = 0; bj < 2; ++bj)
#pragma unroll
                        for (int n = 0; n < 2; ++n) *(f32x4*)(rowp + bj * HALF + n * 16) = acc[ai][bj][m][n]; }
        } else {
            if (MODE == EP_PROJ && sw) {
                const int ch0 = (u.pn - 20) * BM + wr * 64 + fr, tok0 = u.pm * BM + wc * 32 + 8 * fq;
#pragma unroll
                for (int ai = 0; ai < 2; ++ai)
#pragma unroll
                    for (int m = 0; m < 4; ++m) { bf16_t* rowp = HYT + (size_t)(ch0 + ai * HALF + m * 16) * NTOK + tok0;
#pragma unroll
                        for (int bj = 0; bj < 2; ++bj) { const f32x4 v0 = acc[ai][bj][m][0], v1 = acc[ai][bj][m][1];
                            u32x4 o; o.x = pk2(v0[0], v0[1]); o.y = pk2(v0[2], v0[3]); o.z = pk2(v1[0], v1[1]); o.w = pk2(v1[2], v1[3]);
                            *(u32x4*)(rowp + bj * HALF) = o; } }
                return;
            }
            const int row0 = u.pm * BM + wr * 64 + fr, col0 = u.pn * BM + wc * 32 + 8 * fq;
#pragma unroll
            for (int ai = 0; ai < 2; ++ai)
#pragma unroll
                for (int m = 0; m < 4; ++m) { const size_t r = (size_t)(row0 + ai * HALF + m * 16);
#pragma unroll
                    for (int bj = 0; bj < 2; ++bj) { f32x4 v0 = acc[ai][bj][m][0], v1 = acc[ai][bj][m][1]; const int cc = col0 + bj * HALF;
                        if constexpr (MODE == EP_BRA || MODE == EP_BRB) {
                            const u32x4 g = *(const u32x4*)(G + r * NPROJ + cc);
                            v0[0] *= sigmoidf_(bflo(g.x)); v0[1] *= sigmoidf_(bfhi(g.x)); v0[2] *= sigmoidf_(bflo(g.y)); v0[3] *= sigmoidf_(bfhi(g.y));
                            v1[0] *= sigmoidf_(bflo(g.z)); v1[1] *= sigmoidf_(bfhi(g.z)); v1[2] *= sigmoidf_(bflo(g.w)); v1[3] *= sigmoidf_(bfhi(g.w));
                        }
                        if constexpr (MODE == EP_BRB) {
                            const u32x4 t = *(const u32x4*)(T + r * ldc + cc);
                            v0[0] += bflo(t.x); v0[1] += bfhi(t.x); v0[2] += bflo(t.y); v0[3] += bfhi(t.y);
                            v1[0] += bflo(t.z); v1[1] += bfhi(t.z); v1[2] += bflo(t.w); v1[3] += bfhi(t.w);
                        }
                        u32x4 o; o.x = pk2(v0[0], v0[1]); o.y = pk2(v0[2], v0[3]); o.z = pk2(v1[0], v1[1]); o.w = pk2(v1[2], v1[3]);
                        *(u32x4*)(O + r * ldc + cc) = o; } }
        }
    }
};

#ifndef GEMM_SP2
#define GEMM_SP2 1
#endif
#ifndef GEMM_ALIGN
#define GEMM_ALIGN 1
#endif
template <class EpiT, bool ALIGN_EPI = (GEMM_ALIGN != 0), bool SP2 = (GEMM_SP2 != 0)>
__device__ __forceinline__ void gemm_phase(LAS unsigned char* lds, const Gemm g, const StaticOrder& S, const EpiT& E) {
    const int tid = TID(), wid = __builtin_amdgcn_readfirstlane(tid >> 6), lane = tid & 63, wr = wid >> 2, wc = wid & 3, fr = lane & 15, fq = lane >> 4;
    const int K = g.K, nt = K / BK;
    unsigned voffA[2], voffB[2];
#pragma unroll
    for (int i = 0; i < 2; ++i) { int R, C; stage_rc(tid * 16 + i * 8192, R, C); const int Rb = EpiT::PERM ? ((R & ~31) + perm32(R & 31)) : R;
        voffA[i] = (unsigned)(R * K + C) * 2u; voffB[i] = (unsigned)(Rb * K + C) * 2u; }
    const size_t kstep = (size_t)(BK * 2);
    const size_t hstep = (size_t)HALF * K * 2;
    const size_t tstep = 2 * hstep;
    const unsigned ldsw = (unsigned)wid * 1024u;
    const int aoff = lds_byte(wr * 64 + fr, fq * 8), boff = lds_byte(wc * 32 + fr, fq * 8);
#define PG8_SA(b, h) (((b) * 2 + (h)) * HTB)
#define PG8_SB(b, h) ((4 + (b) * 2 + (h)) * HTB)
#define PG8_STAGE(bufoff, gbase, voff) do { _Pragma("unroll") for (int _i = 0; _i < 2; ++_i) \
        __builtin_amdgcn_global_load_lds((const unsigned*)((const char*)(gbase) + (voff)[_i]), (LAS unsigned*)(lds + (bufoff) + ldsw + _i * 8192), 16, 0, 0); } while (0)
#define PG8_LDA(dst, b, h) do { _Pragma("unroll") for (int m = 0; m < 4; ++m) _Pragma("unroll") for (int k = 0; k < 2; ++k) dst[m][k] = *(const LAS bf16x8*)(lds + PG8_SA(b, h) + aoff + m * 2048 + k * 1024); } while (0)
#define PG8_LDB(dst, b, h) do { _Pragma("unroll") for (int n = 0; n < 2; ++n) _Pragma("unroll") for (int k = 0; k < 2; ++k) dst[n][k] = *(const LAS bf16x8*)(lds + PG8_SB(b, h) + boff + n * 2048 + k * 1024); } while (0)
#define PG8_MMA(ai, bj, At, Bt) do { __builtin_amdgcn_s_setprio(1); _Pragma("unroll") for (int m = 0; m < 4; ++m) _Pragma("unroll") for (int n = 0; n < 2; ++n) _Pragma("unroll") for (int k = 0; k < 2; ++k) \
        acc[ai][bj][m][n] = __builtin_amdgcn_mfma_f32_16x16x32_bf16(Bt[n][k], At[m][k], acc[ai][bj][m][n], 0, 0, 0); __builtin_amdgcn_s_setprio(0); } while (0)
#define PG8_WAIT_V(n) asm volatile("s_waitcnt vmcnt(" #n ")" ::: "memory")
#define PG8_WAIT_L(n) asm volatile("s_waitcnt lgkmcnt(" #n ")" ::: "memory")
#define PG8_BAR __builtin_amdgcn_s_barrier()
#define PG8_SCHED __builtin_amdgcn_sched_barrier(0)
    Unit cur, nxt; int ui = 0;
    if (!S.next(0, cur)) return;
    f32x4 acc[2][2][4][2];
#pragma unroll
    for (int a = 0; a < 2; ++a)
#pragma unroll
        for (int b = 0; b < 2; ++b)
#pragma unroll
            for (int m = 0; m < 4; ++m)
#pragma unroll
                for (int n = 0; n < 2; ++n) acc[a][b][m][n] = (f32x4){0.f, 0.f, 0.f, 0.f};
    bf16x8 At[4][2], B0[2][2], B1[2][2];
    bool csw = S.is_sw(cur);
    const char* cA = csw ? (const char*)g.Bt + (size_t)cur.pn * tstep : (const char*)g.A + (size_t)cur.pm * tstep;
    const char* cB = csw ? (const char*)g.A + (size_t)cur.pm * tstep : (const char*)g.Bt + (size_t)cur.pn * tstep;
    if constexpr (SP2) {
        PG8_STAGE(PG8_SB(0, 0), cB, voffB); PG8_STAGE(PG8_SB(0, 1), cB + hstep, voffB); PG8_STAGE(PG8_SA(0, 0), cA, voffA); PG8_STAGE(PG8_SA(0, 1), cA + hstep, voffA);
        if (wr == 1) PG8_BAR;
        PG8_WAIT_V(2); PG8_BAR;
        PG8_STAGE(PG8_SB(1, 0), cB + kstep, voffB); PG8_STAGE(PG8_SA(1, 0), cA + kstep, voffA); PG8_STAGE(PG8_SB(1, 1), cB + hstep + kstep, voffB);
        PG8_WAIT_V(6); PG8_BAR;
    } else {
    PG8_STAGE(PG8_SB(0, 0), cB, voffB); PG8_STAGE(PG8_SA(0, 0), cA, voffA); PG8_STAGE(PG8_SB(0, 1), cB + hstep, voffB); PG8_STAGE(PG8_SA(0, 1), cA + hstep, voffA);
    if (wr == 1) PG8_BAR;
    PG8_WAIT_V(4); PG8_BAR;
    PG8_STAGE(PG8_SB(1, 0), cB + kstep, voffB); PG8_STAGE(PG8_SA(1, 0), cA + kstep, voffA); PG8_STAGE(PG8_SB(1, 1), cB + hstep + kstep, voffB);
    PG8_WAIT_V(6); PG8_BAR;
    }
    for (;;) {
        const bool has_next = S.next(ui + 1, nxt);
        const bool nsw = has_next ? S.is_sw(nxt) : false;
        const char* nA = has_next ? (nsw ? (const char*)g.Bt + (size_t)nxt.pn * tstep : (const char*)g.A + (size_t)nxt.pm * tstep) : cA;
        const char* nB = has_next ? (nsw ? (const char*)g.A + (size_t)nxt.pm * tstep : (const char*)g.Bt + (size_t)nxt.pn * tstep) : cB;
        for (int t = 0; t < nt; t += 2) {
            const bool last = (t == nt - 2);
            const char* a1 = cA + (size_t)(t + 1) * kstep;
            const char* a2 = last ? nA : cA + (size_t)(t + 2) * kstep; const char* b2 = last ? nB : cB + (size_t)(t + 2) * kstep;
            const char* a3 = a2 + kstep; const char* b3 = b2 + kstep;
            if constexpr (SP2) {
            PG8_LDB(B0, 0, 0); PG8_LDB(B1, 0, 1); PG8_SCHED; PG8_LDA(At, 0, 0); PG8_STAGE(PG8_SA(1, 1), a1 + hstep, voffA);
            PG8_WAIT_V(8); PG8_WAIT_L(0); PG8_BAR; PG8_MMA(0, 0, At, B0); PG8_MMA(0, 1, At, B1); PG8_BAR; PG8_SCHED;
            PG8_LDA(At, 0, 1); PG8_STAGE(PG8_SB(0, 0), b2, voffB); PG8_STAGE(PG8_SB(0, 1), b2 + hstep, voffB); PG8_STAGE(PG8_SA(0, 0), a2, voffA);
            PG8_WAIT_V(8); PG8_WAIT_L(0); PG8_BAR; PG8_MMA(1, 0, At, B0); PG8_MMA(1, 1, At, B1); PG8_BAR; PG8_SCHED;
            PG8_LDB(B0, 1, 0); PG8_LDB(B1, 1, 1); PG8_SCHED; PG8_LDA(At, 1, 0); PG8_STAGE(PG8_SA(0, 1), a2 + hstep, voffA);
            PG8_WAIT_V(8); PG8_WAIT_L(0); PG8_BAR; PG8_MMA(0, 0, At, B0); PG8_MMA(0, 1, At, B1); PG8_BAR; PG8_SCHED;
            PG8_LDA(At, 1, 1); PG8_STAGE(PG8_SB(1, 0), b3, voffB); PG8_STAGE(PG8_SB(1, 1), b3 + hstep, voffB); PG8_STAGE(PG8_SA(1, 0), a3, voffA);
            PG8_WAIT_V(8); PG8_WAIT_L(0); PG8_BAR; PG8_MMA(1, 0, At, B0); PG8_MMA(1, 1, At, B1); PG8_BAR; PG8_SCHED;
            } else {
            PG8_LDB(B0, 0, 0); PG8_SCHED; PG8_LDA(At, 0, 0); PG8_STAGE(PG8_SA(1, 1), a1 + hstep, voffA);
            PG8_WAIT_L(8); PG8_BAR; PG8_WAIT_L(0); PG8_MMA(0, 0, At, B0); PG8_BAR; PG8_SCHED;
            PG8_LDB(B1, 0, 1); PG8_STAGE(PG8_SB(0, 0), b2, voffB);
            PG8_BAR; PG8_WAIT_L(0); PG8_MMA(0, 1, At, B1); PG8_BAR;
            PG8_LDA(At, 0, 1); PG8_STAGE(PG8_SA(0, 0), a2, voffA);
            PG8_BAR; PG8_WAIT_L(0); PG8_MMA(1, 0, At, B0); PG8_BAR; PG8_SCHED;
            PG8_STAGE(PG8_SB(0, 1), b2 + hstep, voffB);
            PG8_WAIT_V(6); PG8_BAR; PG8_MMA(1, 1, At, B1); PG8_BAR;
            PG8_LDB(B0, 1, 0); PG8_SCHED; PG8_LDA(At, 1, 0); PG8_STAGE(PG8_SA(0, 1), a2 + hstep, voffA);
            PG8_WAIT_L(8); PG8_BAR; PG8_WAIT_L(0); PG8_MMA(0, 0, At, B0); PG8_BAR; PG8_SCHED;
            PG8_LDB(B1, 1, 1); PG8_STAGE(PG8_SB(1, 0), b3, voffB);
            PG8_BAR; PG8_WAIT_L(0); PG8_MMA(0, 1, At, B1); PG8_BAR;
            PG8_LDA(At, 1, 1); PG8_STAGE(PG8_SA(1, 0), a3, voffA);
            PG8_BAR; PG8_WAIT_L(0); PG8_MMA(1, 0, At, B0); PG8_BAR; PG8_SCHED;
            PG8_STAGE(PG8_SB(1, 1), b3 + hstep, voffB);
            PG8_WAIT_V(6); PG8_BAR; PG8_MMA(1, 1, At, B1); PG8_BAR;
            }
        }
        if constexpr (ALIGN_EPI) { if (wr == 0) PG8_BAR; }
        E(acc, cur, csw, wr, wc, fr, fq);
        if (!has_next) break;
#pragma unroll
        for (int a = 0; a < 2; ++a)
#pragma unroll
            for (int b = 0; b < 2; ++b)
#pragma unroll
                for (int m = 0; m < 4; ++m)
#pragma unroll
                    for (int n = 0; n < 2; ++n) acc[a][b][m][n] = (f32x4){0.f, 0.f, 0.f, 0.f};
        cur = nxt; cA = nA; cB = nB; csw = nsw; ++ui;
        if constexpr (ALIGN_EPI) { if (wr == 1) PG8_BAR; }
    }
    PG8_WAIT_V(0);
    if constexpr (!ALIGN_EPI) { if (wr == 0) PG8_BAR; }
    PG8_BAR;
#undef PG8_SA
#undef PG8_SB
#undef PG8_STAGE
#undef PG8_LDA
#undef PG8_LDB
#undef PG8_MMA
#undef PG8_WAIT_V
#undef PG8_WAIT_L
#undef PG8_BAR
#undef PG8_SCHED
}
}

__device__ __forceinline__ void transpose_item(const float* __restrict__ W, int K, int N, bf16_t* __restrict__ WT, LAS float* scr, int item, int lane) {
    const int nblk = N >> 5, kb = item / nblk, nb = item - kb * nblk, k0 = kb * 64, n0 = nb * 32;
    float v[32];
#pragma unroll
    for (int i = 0; i < 32; ++i) { const int kk = 2 * i + (lane >> 5); v[i] = W[(size_t)(k0 + kk) * N + n0 + (lane & 31)]; }
#pragma unroll
    for (int i = 0; i < 32; ++i) { const int kk = 2 * i + (lane >> 5); scr[kk * 33 + (lane & 31)] = v[i]; }
    asm volatile("s_waitcnt lgkmcnt(0)" ::: "memory");
    const int c = lane & 7;
#pragma unroll
    for (int j = 0; j < 4; ++j) { const int n = (lane >> 3) + 8 * j; const LAS float* s = scr + (8 * c) * 33 + n;
        u32x4 o; o.x = pk2(s[0 * 33], s[1 * 33]); o.y = pk2(s[2 * 33], s[3 * 33]); o.z = pk2(s[4 * 33], s[5 * 33]); o.w = pk2(s[6 * 33], s[7 * 33]);
        *(u32x4*)(WT + (size_t)(n0 + n) * K + k0 + 8 * c) = o; }
    asm volatile("s_waitcnt lgkmcnt(0)" ::: "memory");
}

__device__ __forceinline__ void phase_prologue(PP P, LAS unsigned char* lds) {
    const int tid = TID(), lane = tid & 63, wave = tid >> 6;
    {
        LAS float* s = (LAS float*)lds;
        LAS float* red = (LAS float*)(lds + 40960);
        for (int i = tid; i < 5 * D; i += 512) { const int r = i / D, k = i - r * D; const float v = (r < 4) ? P->in[I_C][r * D + k] : P->in[I_CCTX][k]; s[i] = siluf_(v); }
        __syncthreads();
        for (int it = BID(); it < 256; it += gridDim.x) {
            const int l = it >> 7, col0 = (it & 127) * 96;
            const int cgp = tid % 24, kg = tid / 24;
            float acc[5][4];
#pragma unroll
            for (int r = 0; r < 5; ++r)
#pragma unroll
                for (int i = 0; i < 4; ++i) acc[r][i] = 0.f;
            if (kg < 21) {
                const float* wp = P->in[I_WMOD] + (size_t)l * D * NMOD + col0 + 4 * cgp;
#pragma unroll 7
                for (int k = kg; k < D; k += 21) {
                    const f32x4 w = *(const f32x4*)(wp + (size_t)k * NMOD);
#pragma unroll
                    for (int r = 0; r < 5; ++r) { const float sv = s[r * D + k]; acc[r][0] += sv * w[0]; acc[r][1] += sv * w[1]; acc[r][2] += sv * w[2]; acc[r][3] += sv * w[3]; }
                }
#pragma unroll
                for (int r = 0; r < 5; ++r)
#pragma unroll
                    for (int i = 0; i < 4; ++i) red[(kg * 24 + cgp) * 20 + r * 4 + i] = acc[r][i];
            }
            __syncthreads();
            if (tid < 480) {
                const int cg2 = tid / 20, ri = tid % 20, r = ri >> 2, i = ri & 3;
                float sum = 0.f;
                for (int k2 = 0; k2 < 21; ++k2) sum += red[(k2 * 24 + cg2) * 20 + ri];
                const int col = col0 + 4 * cg2 + i;
                ((float*)(P->ws + WS_MOD))[((size_t)l * 5 + r) * NMOD + col] = sum + P->in[I_BMOD][l * NMOD + col];
            }
            __syncthreads();
        }
    }
    {
        const int gw = BID() * 8 + wave, NGW = gridDim.x * 8;
        for (int idx = gw; idx < 2 * 1280; idx += NGW) {
            const int l = idx / 1280, rr = idx - l * 1280; const int L = rr < 1024 ? 1024 : 256; const int t = rr < 1024 ? rr : rr - 1024;
            const float tf = (float)t, t01 = tf / (float)(L - 1);
            float feat = 0.f;
            if (lane == 0) feat = t01;
            else if (lane <= 32) { const int bi = (lane - 1) & 15; const float band = 1e-4f + (float)bi * ((15.0f - 1e-4f) / 15.0f);
                const float ang = (6.283185307179586f / (float)L) * tf * band; feat = (lane <= 16) ? cosf(ang) : -sinf(ang); }
            const float* w1 = P->in[I_HYW1] + l * 33 * 64; const float* w2 = P->in[I_HYW2] + l * 64 * 64;
            float a1 = P->in[I_HYB1][l * 64 + lane];
            for (int i = 0; i < 33; ++i) a1 += __shfl(feat, i) * w1[i * 64 + lane];
            const float h1 = sinf(a1);
            float a2 = P->in[I_HYB2][l * 64 + lane];
            for (int i = 0; i < 64; ++i) a2 += __shfl(h1, i) * w2[i * 64 + lane];
            ((float*)(P->ws + WS_H2))[(size_t)idx * 64 + lane] = sinf(a2);
        }
    }
    {
        LAS float* scr = (LAS float*)(lds + wave * 8448);
        const int gw = BID() * 8 + wave, NGW = gridDim.x * 8;
        constexpr int I_IN = 32 * 384, I_BR = 16 * 64, I_OUT = 32 * 64, I_UP = 32 * 352, I_DN = 88 * 64, I_LAYER = I_IN + 2 * I_BR + I_OUT + I_UP + I_DN;
        for (int it = gw; it < 2 * I_LAYER; it += NGW) {
            const int l = it / I_LAYER; int r = it - l * I_LAYER;
            if (r < I_IN) { transpose_item(P->in[I_WIN] + (size_t)l * D * NPROJ, D, NPROJ, (bf16_t*)(P->ws + WS_WIN + l * SZ_WIN), scr, r, lane); continue; } r -= I_IN;
            if (r < I_BR) { transpose_item(P->in[I_WA] + (size_t)l * DA * D, DA, D, (bf16_t*)(P->ws + WS_WA + l * SZ_WBR), scr, r, lane); continue; } r -= I_BR;
            if (r < I_BR) { transpose_item(P->in[I_WB] + (size_t)l * DA * D, DA, D, (bf16_t*)(P->ws + WS_WB + l * SZ_WBR), scr, r, lane); continue; } r -= I_BR;
            if (r < I_OUT) { transpose_item(P->in[I_WOUT] + (size_t)l * D * D, D, D, (bf16_t*)(P->ws + WS_WOUT + l * SZ_WOUT), scr, r, lane); continue; } r -= I_OUT;
            if (r < I_UP) { transpose_item(P->in[I_WUP] + (size_t)l * D * NUP, D, NUP, (bf16_t*)(P->ws + WS_WUP + l * SZ_WUP), scr, r, lane); continue; } r -= I_UP;
            transpose_item(P->in[I_WDN] + (size_t)l * DFF * D, DFF, D, (bf16_t*)(P->ws + WS_WDN + l * SZ_WDN), scr, r, lane);
        }
    }
}

__device__ __forceinline__ void prenorm_rows(PP P) {
    const int tid_ = TID(), lane = tid_ & 63, gw = BID() * 8 + (tid_ >> 6), NGW = gridDim.x * 8;
    const float* mod = (const float*)(P->ws + WS_MOD);
    bf16_t* HB = (bf16_t*)(P->ws + WS_HB);
    for (int row = gw; row < NTOK; row += NGW) {
        const float* xr = (row < NCTX) ? P->in[I_XP] + (size_t)row * D : P->in[I_XS] + (size_t)(row - NCTX) * D;
        const int mr = (row < NCTX) ? 4 : ((row - NCTX) >> 10);
        const float* md = mod + (size_t)mr * NMOD;
        f32x4 v[8]; float ss = 0.f;
#pragma unroll
        for (int j = 0; j < 8; ++j) { v[j] = *(const f32x4*)(xr + 4 * lane + 256 * j); ss += v[j][0] * v[j][0] + v[j][1] * v[j][1] + v[j][2] * v[j][2] + v[j][3] * v[j][3]; }
        const float r = rsqrtf(wave_sum(ss) * (1.f / D) + EPS);
#pragma unroll
        for (int j = 0; j < 8; ++j) { const int c = 4 * lane + 256 * j;
            const f32x4 g = *(const f32x4*)(P->in[I_GPREMIX] + c), sh = *(const f32x4*)(md + c), sc = *(const f32x4*)(md + D + c);
            u32x2 o; o.x = pk2(v[j][0] * r * g[0] * (1.f + sc[0]) + sh[0], v[j][1] * r * g[1] * (1.f + sc[1]) + sh[1]);
            o.y = pk2(v[j][2] * r * g[2] * (1.f + sc[2]) + sh[2], v[j][3] * r * g[3] * (1.f + sc[3]) + sh[3]);
            *(u32x2*)(HB + (size_t)row * D + c) = o; }
    }
}
__device__ __forceinline__ void row_phase(PP P, int l, const bf16_t* Y, int which  ) {
    const int tid_ = TID(), lane = tid_ & 63, gw = BID() * 8 + (tid_ >> 6), NGW = gridDim.x * 8;
    const float* mod = (const float*)(P->ws + WS_MOD);
    bf16_t* HB = (bf16_t*)(P->ws + WS_HB);
    const float* gpost = (which == 0 ? P->in[I_GPOSTMIX] : P->in[I_GPOSTFFN]) + l * D;
    const bool do_h = (which == 0) || (l + 1 < 2);
    const int ln = (which == 0) ? l : l + 1;
    const float* gpre = (which == 0 ? P->in[I_GPREFFN] : P->in[I_GPREMIX]) + (do_h ? ln : 0) * D;
    for (int row = gw; row < NTOK; row += NGW) {
        const int mr = (row < NCTX) ? 4 : ((row - NCTX) >> 10);
        const float* md = mod + ((size_t)l * 5 + mr) * NMOD;
        const float* gt = md + (which == 0 ? 2 : 5) * D;
        const float* mdn = mod + ((size_t)(do_h ? ln : 0) * 5 + mr) * NMOD + (which == 0 ? 3 * D : 0);
        const float* xo = (l == 0 && which == 0) ? ((row < NCTX) ? P->in[I_XP] + (size_t)row * D : P->in[I_XS] + (size_t)(row - NCTX) * D) : P->out + (size_t)row * D;
        const bf16_t* yr = Y + (size_t)row * D;
        f32x4 y[8], x[8]; float ss = 0.f;
#pragma unroll
        for (int j = 0; j < 8; ++j) { { const u32x2 yb = *(const u32x2*)(yr + 4 * lane + 256 * j); y[j][0] = bflo(yb.x); y[j][1] = bfhi(yb.x); y[j][2] = bflo(yb.y); y[j][3] = bfhi(yb.y); } x[j] = *(const f32x4*)(xo + 4 * lane + 256 * j);
            ss += y[j][0] * y[j][0] + y[j][1] * y[j][1] + y[j][2] * y[j][2] + y[j][3] * y[j][3]; }
        const float r1 = rsqrtf(wave_sum(ss) * (1.f / D) + EPS);
        float ss2 = 0.f;
#pragma unroll
        for (int j = 0; j < 8; ++j) { const int c = 4 * lane + 256 * j; const f32x4 g = *(const f32x4*)(gpost + c), t = *(const f32x4*)(gt + c);
            x[j][0] += t[0] * (y[j][0] * r1 * g[0]); x[j][1] += t[1] * (y[j][1] * r1 * g[1]); x[j][2] += t[2] * (y[j][2] * r1 * g[2]); x[j][3] += t[3] * (y[j][3] * r1 * g[3]);
            *(f32x4*)(P->out + (size_t)row * D + c) = x[j];
            ss2 += x[j][0] * x[j][0] + x[j][1] * x[j][1] + x[j][2] * x[j][2] + x[j][3] * x[j][3]; }
        if (do_h) {
            const float r2 = rsqrtf(wave_sum(ss2) * (1.f / D) + EPS);
#pragma unroll
            for (int j = 0; j < 8; ++j) { const int c = 4 * lane + 256 * j;
                const f32x4 g = *(const f32x4*)(gpre + c), sh = *(const f32x4*)(mdn + c), sc = *(const f32x4*)(mdn + D + c);
                u32x2 o; o.x = pk2(x[j][0] * r2 * g[0] * (1.f + sc[0]) + sh[0], x[j][1] * r2 * g[1] * (1.f + sc[1]) + sh[1]);
                o.y = pk2(x[j][2] * r2 * g[2] * (1.f + sc[2]) + sh[2], x[j][3] * r2 * g[3] * (1.f + sc[3]) + sh[3]);
                *(u32x2*)(HB + (size_t)row * D + c) = o; }
        }
    }
}

__device__ __forceinline__ void filter_units(PP P, LAS unsigned char* lds) {
    const int tid = TID(), lane = tid & 63, wave = tid >> 6;
    LAS float* h3 = (LAS float*)lds;
    for (int u = BID(); u < 512; u += gridDim.x) {
        const int l = u >> 8, c0 = (u & 255) * 4;
        const float* w3 = P->in[I_HYW3] + (size_t)l * 64 * 4096;
        LAS f32x4* w3s = (LAS f32x4*)(lds + 65536);
        if (tid < 256) { const int k = tid >> 2, q = tid & 3; w3s[tid] = *(const f32x4*)(w3 + (size_t)k * 4096 + q * 1024 + c0); }
        __syncthreads();
        for (int lv = 0; lv < 2; ++lv) {
            const int L = lv == 0 ? 1024 : 256; const int rowoff = lv == 0 ? 0 : 1024;
            for (int t = tid; t < L; t += 512) {
                const float* hr = (const float*)(P->ws + WS_H2) + ((size_t)l * 1280 + rowoff + t) * 64;
                const float t01 = (float)t / (float)(L - 1);
                f32x4 a[4];
#pragma unroll
                for (int q = 0; q < 4; ++q) a[q] = (f32x4){0.f, 0.f, 0.f, 0.f};
#pragma unroll 1
                for (int kc = 0; kc < 4; ++kc) {
                    f32x4 hv[4];
#pragma unroll
                    for (int i = 0; i < 4; ++i) hv[i] = *(const f32x4*)(hr + kc * 16 + 4 * i);
#pragma unroll
                    for (int k = 0; k < 16; ++k) { const float hk = hv[k >> 2][k & 3];
#pragma unroll
                        for (int q = 0; q < 4; ++q) { const f32x4 w = w3s[(kc * 16 + k) * 4 + q]; a[q][0] += hk * w[0]; a[q][1] += hk * w[1]; a[q][2] += hk * w[2]; a[q][3] += hk * w[3]; } }
                }
#pragma unroll
                for (int q = 0; q < 4; ++q) {
                    const int order = q >> 1;
                    const f32x4 dc = *(const f32x4*)(P->in[I_HYDEC] + (l * 2 + order) * 1024 + c0);
#pragma unroll
                    for (int ci = 0; ci < 4; ++ci) h3[(q * 4 + ci) * 1024 + t] = a[q][ci] * __expf(-t01 * fabsf(dc[ci]));
                }
            }
            __syncthreads();
            {
                const int order = wave >> 2, ci = wave & 3;
                const LAS float* hf = h3 + ((order * 2 + 0) * 4 + ci) * 1024; const LAS float* hb = h3 + ((order * 2 + 1) * 4 + ci) * 1024;
                float s = 0.f;
                for (int t = lane; t < L; t += 64) s += (t == 0) ? fabsf(hf[0] + hb[0]) : (fabsf(hf[t]) + fabsf(hb[t]));
                const float inv = 1.f / (wave_sum(s) + EPS);
                bf16_t* F = (bf16_t*)(P->ws + WS_FILT) + (size_t)l * FILT_L + (lv == 0 ? 0 : (size_t)2 * 1024 * 2048) + ((size_t)order * 1024 + c0 + ci) * (2 * L);
                for (int i = lane; i < 2 * L; i += 64) { const int lag = L - i;
                    float v; if (i == 0) v = 0.f; else if (lag > 0) v = hf[lag]; else if (lag == 0) v = hf[0] + hb[0]; else v = hb[-lag];
                    F[i] = f2bf(v * inv); }
            }
            __syncthreads();
        }
    }
}

__device__ __forceinline__ void scan_unit(PP P, int l, LAS unsigned char* lds, int path, int b, int h, int dir) {
    const int tid = TID(), lane = tid & 63, w = tid >> 6;
    const int L = path ? 1024 : 256, tb = path ? NCTX + b * 1024 : b * 256, nch = L >> 5;
    const bf16_t* proj = (const bf16_t*)(P->ws + WS_A);
    float* OP = (float*)(P->ws + WS_B + SZ_HYT) + (size_t)dir * NTOK * DA;
    const __amdgpu_buffer_rsrc_t ors = __builtin_amdgcn_make_buffer_rsrc((void*)OP, 0, (int)((size_t)NTOK * DA * 4), 0x00020000);
    constexpr int QB = 0, KB = 8704, KDT = 17408, VT0 = 27648, VTS = 10240, SB0 = 48128, SBS = 34816, ATT = 117760, GSUM = 120320, DEC = 122368;
    const int d = tid & 127, tg = tid >> 7;
    float lb = 0.f;
    if (l == 1) { const float x0 = P->in[I_LB][(0 * 2 + dir) * DA + h * 128 + d], x1 = P->in[I_LB][(1 * 2 + dir) * DA + h * 128 + d]; lb = __builtin_amdgcn_rcpf(1.f + __expf(x0 - x1)); }
    const float oml = 1.f - lb;
    const int et = w & 3, dtb = (w >> 2) * 4, fr = lane & 15, fq = lane >> 4;
    f32x4 st[2][4];
#pragma unroll
    for (int s2 = 0; s2 < 2; ++s2)
#pragma unroll
        for (int i = 0; i < 4; ++i) {
            st[s2][i] = (f32x4){0.f, 0.f, 0.f, 0.f};
            if (path) { const int dd = (dtb + i) * 16 + fq * 4, ee = s2 * 64 + et * 16 + fr;
                const float* sp = P->in[I_STATE] + ((((size_t)(b * 2 + l) * 2 + dir) * 8 + h) * 128 + dd) * 128 + ee;
                st[s2][i][0] = sp[0]; st[s2][i][1] = sp[128]; st[s2][i][2] = sp[256]; st[s2][i][3] = sp[384]; }
        }
    const int ve = tid & 127, vjg = tid >> 7;
    bf16_t qr[8], fz[8], vr[8], qr2[8], fz2[8], vr2[8];
    auto tokof = [&](int c, int j) { const int p = c * 32 + j; return tb + (dir ? (L - 1 - p) : p); };
    const __amdgpu_buffer_rsrc_t prs = __builtin_amdgcn_make_buffer_rsrc((void*)proj, 0, (int)((size_t)NTOK * NPROJ * 2), 0x00020000);
    const unsigned voff0 = (unsigned)(tb + (dir ? (L - 1 - (tg * 8 + 7)) : tg * 8)) * (unsigned)(NPROJ * 2) + (unsigned)((h * 128 + d) * 2);
    const int vstep = dir ? -(32 * NPROJ * 2) : (32 * NPROJ * 2);
    const int fcol = 2048 * (1 + dir);
    auto load_chunk = [&](int c, bf16_t (&q_)[8], bf16_t (&f_)[8], bf16_t (&v_)[8]) {
        const unsigned vo = voff0 + (unsigned)(c * vstep);
#pragma unroll
        for (int i = 0; i < 8; ++i) { const int ro = (dir ? (7 - i) : i) * (NPROJ * 2);
            q_[i] = __builtin_amdgcn_raw_buffer_load_b16(prs, vo, ro, 0); f_[i] = __builtin_amdgcn_raw_buffer_load_b16(prs, vo, ro + fcol, 0); v_[i] = __builtin_amdgcn_raw_buffer_load_b16(prs, vo, ro + 6144, 0); }
    };
    load_chunk(0, qr, fz, vr);
    load_chunk(1, qr2, fz2, vr2);
    float pre[8], kk[8];
    auto part1 = [&](int c) {
        const int SB = SB0 + (c & 1) * SBS, VT = VT0 + (c & 1) * VTS;
        float run = 0.f;
#pragma unroll
        for (int i = 0; i < 8; ++i) { const float z = bf2f(fz[i]); const float e = __expf(-fabsf(z)), r = __builtin_amdgcn_rcpf(1.f + e);
            const float sp = z >= 0.f ? r : e * r, sn = z >= 0.f ? e * r : r;
            run += __logf(lb + oml * sp); pre[i] = run; kk[i] = oml * sn; }
        ((LAS float*)(lds + GSUM))[tg * 128 + d] = run;
#pragma unroll
        for (int s2 = 0; s2 < 2; ++s2)
#pragma unroll
            for (int i = 0; i < 4; ++i) { u32x2 o; o.x = pk2(st[s2][i][0], st[s2][i][1]); o.y = pk2(st[s2][i][2], st[s2][i][3]);
                *(LAS u32x2*)(lds + SB + ((s2 * 64 + et * 16 + fr) * 136 + (dtb + i) * 16 + fq * 4) * 2) = o; }
        { u32x4 o; o.x = (unsigned)vr[0] | ((unsigned)vr[1] << 16); o.y = (unsigned)vr[2] | ((unsigned)vr[3] << 16); o.z = (unsigned)vr[4] | ((unsigned)vr[5] << 16); o.w = (unsigned)vr[6] | ((unsigned)vr[7] << 16);
          *(LAS u32x4*)(lds + VT + (ve * 40 + vjg * 8) * 2) = o; }
    };
    part1(0);
    LBAR();
#pragma unroll 1
    for (int c = 0; c < nch; ++c) {
        const int SB = SB0 + (c & 1) * SBS, VT = VT0 + (c & 1) * VTS;
        {
            const LAS float* gs = (const LAS float*)(lds + GSUM);
            const float g0 = gs[d], g1 = gs[128 + d], g2 = gs[256 + d], g3 = gs[384 + d];
            const float tot = g0 + g1 + g2 + g3;
            const float off = (tg == 0) ? 0.f : (tg == 1) ? g0 : (tg == 2) ? (g0 + g1) : (g0 + g1 + g2);
            const float etot = __expf(tot);
            float kd[8];
#pragma unroll
            for (int i = 0; i < 8; ++i) { const float bj = off + pre[i]; const int j = tg * 8 + i;
                const float q = bf2f(qr[i]); const float eb = __expf(bj), ebi = __expf(-bj);
                ((LAS bf16_t*)(lds + QB))[j * 136 + d] = f2bf(siluf_(q) * eb);
                const float kb = kk[i] * ebi;
                ((LAS bf16_t*)(lds + KB))[j * 136 + d] = f2bf(kb);
                kd[i] = kb * etot; }
            u32x4 o; o.x = pk2(kd[0], kd[1]); o.y = pk2(kd[2], kd[3]); o.z = pk2(kd[4], kd[5]); o.w = pk2(kd[6], kd[7]);
            *(LAS u32x4*)(lds + KDT + (d * 40 + tg * 8) * 2) = o;
            if (tg == 0) ((LAS float*)(lds + DEC))[d] = etot;
        }
        LBAR();
#pragma unroll
        for (int i = 0; i < 8; ++i) { qr[i] = qr2[i]; fz[i] = fz2[i]; vr[i] = vr2[i]; }
        if (c + 2 < nch) load_chunk(c + 2, qr2, fz2, vr2);
        const int tt = w >> 2;
        f32x4 acco[2];
#pragma unroll
        for (int s2 = 0; s2 < 2; ++s2) {
            acco[s2] = (f32x4){0.f, 0.f, 0.f, 0.f};
#pragma unroll
            for (int k4 = 0; k4 < 4; ++k4) {
                const bf16x8 a = *(const LAS bf16x8*)(lds + QB + ((tt * 16 + fr) * 136 + k4 * 32 + 8 * fq) * 2);
                const bf16x8 bb = *(const LAS bf16x8*)(lds + SB + ((s2 * 64 + et * 16 + fr) * 136 + k4 * 32 + 8 * fq) * 2);
                acco[s2] = __builtin_amdgcn_mfma_f32_16x16x32_bf16(a, bb, acco[s2], 0, 0, 0);
            }
        }
        if (w < 4) {
            const int tt2 = w >> 1, s2 = w & 1;
            f32x4 aa = (f32x4){0.f, 0.f, 0.f, 0.f};
            if (!(tt2 == 0 && s2 == 1)) {
#pragma unroll
                for (int k4 = 0; k4 < 4; ++k4) {
                    const bf16x8 a = *(const LAS bf16x8*)(lds + QB + ((tt2 * 16 + fr) * 136 + k4 * 32 + 8 * fq) * 2);
                    const bf16x8 bb = *(const LAS bf16x8*)(lds + KB + ((s2 * 16 + fr) * 136 + k4 * 32 + 8 * fq) * 2);
                    aa = __builtin_amdgcn_mfma_f32_16x16x32_bf16(a, bb, aa, 0, 0, 0);
                }
            }
#pragma unroll
            for (int rg = 0; rg < 4; ++rg) { const int t = tt2 * 16 + fq * 4 + rg, s = s2 * 16 + fr;
                ((LAS bf16_t*)(lds + ATT))[t * 40 + s] = f2bf(s <= t ? aa[rg] : 0.f); }
        }
#pragma unroll
        for (int s2 = 0; s2 < 2; ++s2) {
            const bf16x8 vb = *(const LAS bf16x8*)(lds + VT + ((s2 * 64 + et * 16 + fr) * 40 + 8 * fq) * 2);
#pragma unroll
            for (int i = 0; i < 4; ++i) {
                const f32x4 dv = *(const LAS f32x4*)(lds + DEC + ((dtb + i) * 16 + fq * 4) * 4);
                const bf16x8 ka = *(const LAS bf16x8*)(lds + KDT + (((dtb + i) * 16 + fr) * 40 + 8 * fq) * 2);
                const f32x4 s0 = st[s2][i] * dv;
                st[s2][i] = __builtin_amdgcn_mfma_f32_16x16x32_bf16(ka, vb, s0, 0, 0, 0);
            }
        }
        if (c + 1 < nch) part1(c + 1);
        LBAR();
        {
            const unsigned ovo = (unsigned)(tb + (dir ? (L - 1 - (c * 32 + tt * 16 + fq * 4 + 3)) : (c * 32 + tt * 16 + fq * 4))) * (unsigned)(DA * 4) + (unsigned)((h * 128 + et * 16 + fr) * 4);
            const bf16x8 a = *(const LAS bf16x8*)(lds + ATT + ((tt * 16 + fr) * 40 + 8 * fq) * 2);
#pragma unroll
            for (int s2 = 0; s2 < 2; ++s2) {
                const bf16x8 bb = *(const LAS bf16x8*)(lds + VT + ((s2 * 64 + et * 16 + fr) * 40 + 8 * fq) * 2);
                acco[s2] = __builtin_amdgcn_mfma_f32_16x16x32_bf16(a, bb, acco[s2], 0, 0, 0);
#pragma unroll
                for (int rg = 0; rg < 4; ++rg) __builtin_amdgcn_raw_buffer_store_b32(__float_as_uint(acco[s2][rg]), ors, ovo, (dir ? (3 - rg) : rg) * (DA * 4) + s2 * 256, 0);
            }
        }
    }
    LBAR();
    if (!path) {
        float* ns = P->out + (size_t)2 * NCTX * D;
#pragma unroll
        for (int s2 = 0; s2 < 2; ++s2)
#pragma unroll
            for (int i = 0; i < 4; ++i) { const int dd = (dtb + i) * 16 + fq * 4, ee = s2 * 64 + et * 16 + fr;
                float* sp = ns + ((((size_t)(b * 2 + l) * 2 + dir) * 8 + h) * 128 + dd) * 128 + ee;
                sp[0] = st[s2][i][0]; sp[128] = st[s2][i][1]; sp[256] = st[s2][i][2]; sp[384] = st[s2][i][3]; }
    }
}

struct HyRegs { u32x4 raw[3]; bf16_t prev[3], next[3]; u32x4 filt; };
__device__ __forceinline__ void hy_issue(PP P, int l, unsigned u, HyRegs& R) {
    const int tid = TID();
    const int lat = (int)(((u >> 8) + u) & 1u), c = (int)(u >> 1);
    const int L = lat ? 1024 : 256, TOK0 = lat ? NCTX : 0;
    const bf16_t* HYT = (const bf16_t*)(P->ws + WS_B);
    const int g8 = tid * 8, t = g8 & (L - 1);
#pragma unroll
    for (int sec = 0; sec < 3; ++sec) {
        const bf16_t* row = HYT + (size_t)(sec * 1024 + c) * NTOK + TOK0;
        R.raw[sec] = *(const u32x4*)(row + g8);
        R.prev[sec] = (t > 0) ? row[g8 - 1] : (bf16_t)0; R.next[sec] = (t + 8 < L) ? row[g8 + 8] : (bf16_t)0;
    }
    const bf16_t* F = (const bf16_t*)(P->ws + WS_FILT) + (size_t)l * FILT_L + (lat ? 0 : (size_t)2 * 1024 * 2048);
    const int NCH = 2 * L / 8;
    R.filt = (u32x4){0u, 0u, 0u, 0u};
    if (tid < 2 * NCH) { const int order = tid / NCH, j = tid - order * NCH; R.filt = *(const u32x4*)(F + ((size_t)order * 1024 + c) * (2 * L) + 8 * j); }
}
template <bool LAT>
__device__ __forceinline__ unsigned hyena_unit(PP P, int l, LAS unsigned char* lds, int c, HyRegs& R, unsigned* ctr, volatile LAS unsigned* qs) {
    constexpr int L = LAT ? 1024 : 256, NB = LAT ? 4 : 16, ZS = L + 136, RLEN = 2 * L + 136, TOK0 = LAT ? NCTX : 0;
    constexpr int SZ_Z = NB * ZS * 2, OFF_Z = 0, OFF_Z2 = SZ_Z, OFF_X1 = 2 * SZ_Z, OFF_X2 = OFF_X1 + 8192, OFF_R = OFF_X2 + 8192;
    const int tid = TID(), lane = tid & 63, w = tid >> 6, fr = lane & 15, fq = lane >> 4;
    bf16_t* OB = (bf16_t*)(P->ws + WS_OB);
    unsigned nreg = 0u;
    if (tid == 0) nreg = __hip_atomic_fetch_add(ctr, 1u, __ATOMIC_RELAXED, __HIP_MEMORY_SCOPE_AGENT);
    for (int i = tid; i < 2 * NB * 136; i += 512) { const int a = i / (NB * 136), r = (i / 136) % NB, p = i % 136; const int pos = p < 64 ? p : (L + p);
        ((LAS bf16_t*)(lds + (a ? OFF_Z2 : OFF_Z)))[r * ZS + pos] = 0; }
    {
        const int g8 = tid * 8, bb = g8 / L, t = g8 % L;
#pragma unroll
        for (int sec = 0; sec < 3; ++sec) {
            const int ch3 = sec * 1024 + c;
            const u32x4 raw = R.raw[sec];
            float x[10];
            x[0] = bf2f(R.prev[sec]); x[9] = bf2f(R.next[sec]);
            x[1] = bflo(raw.x); x[2] = bfhi(raw.x); x[3] = bflo(raw.y); x[4] = bfhi(raw.y); x[5] = bflo(raw.z); x[6] = bfhi(raw.z); x[7] = bflo(raw.w); x[8] = bfhi(raw.w);
            const float w0 = P->in[I_HYCW][(l * 3 + 0) * 3072 + ch3], w1 = P->in[I_HYCW][(l * 3 + 1) * 3072 + ch3], w2 = P->in[I_HYCW][(l * 3 + 2) * 3072 + ch3], bi = P->in[I_HYCB][l * 3072 + ch3];
            float y[8];
#pragma unroll
            for (int i = 0; i < 8; ++i) y[i] = w0 * x[i] + w1 * x[i + 1] + w2 * x[i + 2] + bi;
            u32x4 o; o.x = pk2(y[0], y[1]); o.y = pk2(y[2], y[3]); o.z = pk2(y[4], y[5]); o.w = pk2(y[6], y[7]);
            if (sec == 0) *(LAS u32x4*)(lds + OFF_Z + (bb * ZS + 64 + t) * 2) = o;
            else *(LAS u32x4*)(lds + (sec == 1 ? OFF_X1 : OFF_X2) + (bb * L + t) * 2) = o;
        }
    }
    {
        constexpr int NCH = 2 * L / 8;
        LAS bf16_t* Rl = (LAS bf16_t*)(lds + OFF_R);
        if (tid < 2 * NCH) { const int order = tid / NCH, j = tid - order * NCH;
            const u32x4 f = R.filt;
            *(LAS u32x4*)(lds + OFF_R + ((order * 2 + 0) * RLEN + 64 + 8 * j) * 2) = f;
            LAS bf16_t* r1 = Rl + (order * 2 + 1) * RLEN + 63 + 8 * j;
            r1[0] = (bf16_t)(f.x & 0xffffu); r1[1] = (bf16_t)(f.x >> 16); r1[2] = (bf16_t)(f.y & 0xffffu); r1[3] = (bf16_t)(f.y >> 16);
            r1[4] = (bf16_t)(f.z & 0xffffu); r1[5] = (bf16_t)(f.z >> 16); r1[6] = (bf16_t)(f.w & 0xffffu); r1[7] = (bf16_t)(f.w >> 16); }
        for (int i = tid; i < 4 * 136; i += 512) { const int oc = i / 136, q = i - oc * 136, cp = oc & 1; const int lo = 64 - cp;
            const int p = q < lo ? q : (2 * L + q); Rl[oc * RLEN + p] = 0; }
    }
    LBAR();
    unsigned un = 0xffffffffu;
#pragma unroll 1
    for (int order = 0; order < 2; ++order) {
        const int zin = order == 0 ? OFF_Z : OFF_Z2;
        const float bias = P->in[I_HYBIAS][(l * 2 + order) * 1024 + c];
        const int nb_ = LAT ? (fr & 3) : fr, m_ = LAT ? (fr >> 2) : 0;
        f32x4 acc2[2];
        acc2[0] = (f32x4){0.f, 0.f, 0.f, 0.f}; acc2[1] = (f32x4){0.f, 0.f, 0.f, 0.f};
        constexpr int TB = LAT ? 64 : 16, S0 = LAT ? -64 : 0, NIT = (L - S0) / 32;
        const int t0a = (w * 2) * TB;
        const int cp = fr & 1, p0 = L + 64 - (t0a - S0) - fr + 8 * fq;
        const LAS unsigned* rpa = (const LAS unsigned*)(lds + OFF_R + ((order * 2 + cp) * RLEN) * 2) + ((p0 - cp) >> 1);
        const LAS unsigned char* zp = lds + zin + (nb_ * ZS + 64 + S0 + 16 * m_ + 8 * fq) * 2;
        if constexpr (LAT) {
            u32x4 ap2, ap1;
            { const LAS unsigned* r2 = rpa - 32; const LAS unsigned* r1 = rpa - 16;
              ap2.x = r2[0]; ap2.y = r2[1]; ap2.z = r2[2]; ap2.w = r2[3]; ap1.x = r1[0]; ap1.y = r1[1]; ap1.z = r1[2]; ap1.w = r1[3]; }
#pragma unroll 2
            for (int it = 0; it < NIT; it += 2) {
                u32x4 a0, a1; const LAS unsigned* ra = rpa + it * 16;
                a0.x = ra[0]; a0.y = ra[1]; a0.z = ra[2]; a0.w = ra[3]; a1.x = ra[16]; a1.y = ra[17]; a1.z = ra[18]; a1.w = ra[19];
                const bf16x8 b0 = *(const LAS bf16x8*)(zp + it * 64), b1 = *(const LAS bf16x8*)(zp + it * 64 + 64);
                acc2[0] = __builtin_amdgcn_mfma_f32_16x16x32_bf16(__builtin_bit_cast(bf16x8, a0), b0, acc2[0], 0, 0, 0);
                acc2[1] = __builtin_amdgcn_mfma_f32_16x16x32_bf16(__builtin_bit_cast(bf16x8, ap2), b0, acc2[1], 0, 0, 0);
                acc2[0] = __builtin_amdgcn_mfma_f32_16x16x32_bf16(__builtin_bit_cast(bf16x8, a1), b1, acc2[0], 0, 0, 0);
                acc2[1] = __builtin_amdgcn_mfma_f32_16x16x32_bf16(__builtin_bit_cast(bf16x8, ap1), b1, acc2[1], 0, 0, 0);
                ap2 = a0; ap1 = a1;
            }
        } else {
#pragma unroll 2
            for (int it = 0; it < NIT; it += 2) {
                u32x4 av[2][2]; bf16x8 bv[2];
#pragma unroll
                for (int k = 0; k < 2; ++k) {
                    const LAS unsigned* ra = rpa + (it + k) * 16; const LAS unsigned* rb = ra - TB / 2;
                    av[k][0].x = ra[0]; av[k][0].y = ra[1]; av[k][0].z = ra[2]; av[k][0].w = ra[3];
                    av[k][1].x = rb[0]; av[k][1].y = rb[1]; av[k][1].z = rb[2]; av[k][1].w = rb[3];
                    bv[k] = *(const LAS bf16x8*)(zp + (it + k) * 64);
                }
#pragma unroll
                for (int k = 0; k < 2; ++k) {
                    acc2[0] = __builtin_amdgcn_mfma_f32_16x16x32_bf16(__builtin_bit_cast(bf16x8, av[k][0]), bv[k], acc2[0], 0, 0, 0);
                    acc2[1] = __builtin_amdgcn_mfma_f32_16x16x32_bf16(__builtin_bit_cast(bf16x8, av[k][1]), bv[k], acc2[1], 0, 0, 0);
                }
            }
        }
#pragma unroll
        for (int tb2 = 0; tb2 < 2; ++tb2) {
            const int t0 = t0a + tb2 * TB; const f32x4 acc = acc2[tb2];
            const int tq = t0 + 16 * m_ + fq * 4;
            const u32x2 zr = *(const LAS u32x2*)(lds + zin + (nb_ * ZS + 64 + tq) * 2);
            const u32x2 xr = *(const LAS u32x2*)(lds + (order == 0 ? OFF_X1 : OFF_X2) + (nb_ * L + tq) * 2);
            float r0 = bflo(xr.x) * (acc[0] + bias * bflo(zr.x)), r1 = bfhi(xr.x) * (acc[1] + bias * bfhi(zr.x));
            float r2 = bflo(xr.y) * (acc[2] + bias * bflo(zr.y)), r3 = bfhi(xr.y) * (acc[3] + bias * bfhi(zr.y));
            if (order == 0) { u32x2 o; o.x = pk2(r0, r1); o.y = pk2(r2, r3); *(LAS u32x2*)(lds + OFF_Z2 + (nb_ * ZS + 64 + tq) * 2) = o; }
            else { bf16_t* op = OB + (size_t)(TOK0 + nb_ * L + tq) * DA + c; op[0] = f2bf(r0); op[DA] = f2bf(r1); op[2 * DA] = f2bf(r2); op[3 * DA] = f2bf(r3); }
        }
        if (order == 0 && tid == 0) qs[0] = nreg;
        LBAR();
        if (order == 0) { un = qs[0]; if (un < 2048u) hy_issue(P, l, un, R); }
    }
    return un;
}

#ifndef DUP_SCAN
#define DUP_SCAN 0
#endif
#ifndef DUP_HY
#define DUP_HY 0
#endif
__device__ __forceinline__ void phase_mixers(PP P, int l, LAS unsigned char* lds) {
    for (int rep = 0; rep < 1 + DUP_SCAN; ++rep) {
    if (gridDim.x == 256) {
        const int bid = BID();
        if (bid < 64) scan_unit(P, l, lds, 1, bid >> 4, (bid >> 1) & 7, bid & 1);
        else { const int v = bid - 64; scan_unit(P, l, lds, 0, v >> 4, (v >> 1) & 7, v & 1);
               if (v < 64) { const int v2 = v + 192; scan_unit(P, l, lds, 0, v2 >> 4, (v2 >> 1) & 7, v2 & 1); } }
    } else {
        for (int slot = BID(); slot < 320; slot += gridDim.x) {
            if (slot < 64) scan_unit(P, l, lds, 1, slot >> 4, (slot >> 1) & 7, slot & 1);
            else { const int v = slot - 64; scan_unit(P, l, lds, 0, v >> 4, (v >> 1) & 7, v & 1); }
        }
    }
    __syncthreads();
    }
    unsigned* ctr = (unsigned*)(P->ws + WS_BAR) + 64 * l;
    volatile LAS unsigned* qs = (volatile LAS unsigned*)(lds + 131072 + 8);
    if (threadIdx.x == 0) qs[0] = __hip_atomic_fetch_add(ctr, 1u, __ATOMIC_RELAXED, __HIP_MEMORY_SCOPE_AGENT);
    __syncthreads();
    unsigned u = qs[0];
    __syncthreads();
    HyRegs R;
    if (u < 2048u) hy_issue(P, l, u, R);
    while (u < 2048u) {
        const int path = (int)(((u >> 8) + u) & 1u), c = (int)(u >> 1);
        u = path ? hyena_unit<true>(P, l, lds, c, R, ctr, qs) : hyena_unit<false>(P, l, lds, c, R, ctr, qs);
    }
}

__device__ __forceinline__ void phase_combine(PP P, int l) {
    const int tid_ = TID(), lane = tid_ & 63, gw = BID() * 8 + (tid_ >> 6), NGW = gridDim.x * 8;
    const float* OP = (const float*)(P->ws + WS_B + SZ_HYT);
    const bf16_t* proj = (const bf16_t*)(P->ws + WS_A);
    bf16_t* OA = (bf16_t*)(P->ws + WS_OA);
    const int li = lane & 31, half = lane >> 5;
    const f32x4 wn = *(const f32x4*)(P->in[I_HNORM] + l * 128 + 4 * li);
    for (int it = gw; it < NTOK * 4; it += NGW) {
        const int item = it * 2 + half, tok = item >> 3, h = item & 7;
        const size_t off = (size_t)tok * DA + h * 128 + 4 * li;
        f32x4 o = *(const f32x4*)(OP + off); const f32x4 o2 = *(const f32x4*)(OP + (size_t)NTOK * DA + off);
        o[0] += o2[0]; o[1] += o2[1]; o[2] += o2[2]; o[3] += o2[3];
        float ss = o[0] * o[0] + o[1] * o[1] + o[2] * o[2] + o[3] * o[3];
#pragma unroll
        for (int s = 1; s < 32; s <<= 1) ss += __shfl_xor(ss, s);
        const float r = rsqrtf(ss * (1.f / 128.f) + EPS);
        const u32x2 g = *(const u32x2*)(proj + (size_t)tok * NPROJ + 4096 + h * 128 + 4 * li);
        u32x2 out; out.x = pk2(o[0] * r * wn[0] * siluf_(bflo(g.x)), o[1] * r * wn[1] * siluf_(bfhi(g.x)));
        out.y = pk2(o[2] * r * wn[2] * siluf_(bflo(g.y)), o[3] * r * wn[3] * siluf_(bfhi(g.y)));
        *(u32x2*)(OA + off) = out;
    }
}

typedef float f32x2 __attribute__((ext_vector_type(2)));
template <bool LAT>
__device__ __forceinline__ void ffn_sweep2(const bf16_t* __restrict__ U, bf16_t* __restrict__ ACT, const float* __restrict__ cw, const float* __restrict__ cb,
                                           int tok0, int xstart, bool rup, bool rdn, int c2) {
    constexpr int NI = LAT ? 4 : 2, NK = LAT ? 3 : 1, W = LAT ? 64 : 256, GS = 4, NG = 32 / GS;
    f32x2 wa[NK][3], wv[NK][3];
#pragma unroll
    for (int ry = 0; ry < NK; ++ry)
#pragma unroll
        for (int kx = 0; kx < 3; ++kx) { const int ky = LAT ? ry : 1; const float* wp = cw + (size_t)(ky * 3 + kx) * NUP + c2;
            wa[ry][kx] = *(const f32x2*)wp; wv[ry][kx] = *(const f32x2*)(wp + DFF); }
    const f32x2 ba = *(const f32x2*)(cb + c2), bv = *(const f32x2*)(cb + DFF + c2);
    unsigned ca[GS + 2][NI], cv[GS + 2][NI], na[GS][NI], nv[GS][NI];
    auto ld = [&](int x, unsigned (&a)[NI], unsigned (&v)[NI]) {
#pragma unroll
        for (int i = 0; i < NI; ++i) {
            const int xi = LAT ? x : x + 32 * i;
            const bool ok = (xi >= 0) && (xi < W) && (!LAT || (i == 0 ? rup : (i == 3 ? rdn : true)));
            a[i] = 0u; v[i] = 0u;
            if (ok) { const size_t off = (size_t)(tok0 + (x - xstart) + (LAT ? (i - 1) * 64 : 32 * i)) * NUP + c2; a[i] = *(const unsigned*)(U + off); v[i] = *(const unsigned*)(U + off + DFF); }
        }
    };
#pragma unroll
    for (int k = 0; k < GS + 2; ++k) ld(xstart - 1 + k, ca[k], cv[k]);
#pragma unroll 1
    for (int g = 0; g < NG; ++g) {
        const int x = xstart + GS * g;
        if (g < NG - 1) {
#pragma unroll
            for (int k = 0; k < GS; ++k) ld(x + GS + 1 + k, na[k], nv[k]);
        }
#pragma unroll
        for (int st = 0; st < GS; ++st) {
#pragma unroll
            for (int o = 0; o < 2; ++o) {
                f32x2 sa = ba, sv = bv;
#pragma unroll
                for (int ry = 0; ry < NK; ++ry)
#pragma unroll
                    for (int kx = 0; kx < 3; ++kx) { const unsigned a = ca[st + kx][LAT ? (o + ry) : o], v = cv[st + kx][LAT ? (o + ry) : o];
                        sa += wa[ry][kx] * (f32x2){bflo(a), bfhi(a)}; sv += wv[ry][kx] * (f32x2){bflo(v), bfhi(v)}; }
                *(unsigned*)(ACT + (size_t)(tok0 + GS * g + st + (LAT ? 64 * o : 32 * o)) * DFF + c2) = pk2(siluf_(sa[0]) * sv[0], siluf_(sa[1]) * sv[1]);
            }
        }
#pragma unroll
        for (int i = 0; i < NI; ++i) { ca[0][i] = ca[GS][i]; ca[1][i] = ca[GS + 1][i]; cv[0][i] = cv[GS][i]; cv[1][i] = cv[GS + 1][i];
#pragma unroll
            for (int k = 0; k < GS; ++k) { ca[2 + k][i] = na[k][i]; cv[2 + k][i] = nv[k][i]; } }
    }
}
__device__ __forceinline__ void phase_ffnconv(PP P, int l) {
    const int tid = TID();
    const bf16_t* U = (const bf16_t*)(P->ws + WS_A);
    bf16_t* ACT = (bf16_t*)(P->ws + WS_B);
    const float* cw = P->in[I_FCW] + (size_t)l * 9 * NUP; const float* cb = P->in[I_FCB] + (size_t)l * NUP;
    for (int blk = BID(); blk < 256; blk += gridDim.x) {
        const int v = (gridDim.x == 256) ? ((blk & 7) * 32 + (blk >> 3)) : blk;
        const int lu = v >> 2, qt = v & 3;
        for (int idx = tid; idx < 1408; idx += 512) {
            if (idx < 704) { const int bb = lu >> 4, rp = (lu >> 1) & 7, xh = lu & 1, r = 2 * rp;
                ffn_sweep2<true>(U, ACT, cw, cb, NCTX + bb * 1024 + r * 64 + xh * 32, xh * 32, r > 0, r + 2 < 16, 2 * (qt * 704 + idx)); }
            else { const int bb = lu >> 2, sp = lu & 3;
                ffn_sweep2<false>(U, ACT, cw, cb, bb * 256 + sp * 64, sp * 64, true, true, 2 * (qt * 704 + idx - 704)); }
        }
    }
}

#define XB_TMO      128
#define XB_XCNT(j)  (256  + 64 * (j))
#define XB_XSUB(j)  (1280 + 64 * (j))
#define XB_XGEN(j)  (2304 + 64 * (j))
#define XB_TOP      3328
#define XB_TOPGEN   3392
#define XCD_BAR_WORDS 3456
#define XB_SPIN_CAP (1u << 18)
__device__ __forceinline__ unsigned xb_ld(unsigned* p)              { return __hip_atomic_load(p, __ATOMIC_RELAXED, __HIP_MEMORY_SCOPE_AGENT); }
__device__ __forceinline__ unsigned xb_add(unsigned* p, unsigned v) { return __hip_atomic_fetch_add(p, v, __ATOMIC_RELAXED, __HIP_MEMORY_SCOPE_AGENT); }
__device__ __forceinline__ unsigned xb_xcc_id() { return (unsigned)__builtin_amdgcn_s_getreg((3 << 11) | 20) & 0xFu; }
#define XB_SPIN(cond, bar) do { unsigned _sp = 0; while (cond) { __builtin_amdgcn_s_sleep(1); \
    if ((++_sp & 255u) == 0u) { if (xb_ld(&(bar)[XB_TMO])) break; if (_sp > XB_SPIN_CAP) { atomicAdd(&(bar)[XB_TMO], 1u); break; } } } } while (0)
struct XcdBarrier { unsigned* bar; unsigned x; volatile LAS unsigned* st; };
__device__ __forceinline__ XcdBarrier xcd_barrier_post(unsigned* bar, volatile LAS unsigned* st) {
    XcdBarrier b; b.bar = bar; b.x = xb_xcc_id(); b.st = st;
    if (threadIdx.x == 0) (void)xb_add(&bar[XB_XCNT(b.x)], 1u);
    return b;
}
__device__ __forceinline__ void xcd_barrier_complete(unsigned* bar, unsigned x, unsigned& nloc, unsigned& nx) {
    const unsigned G = gridDim.x * gridDim.y * gridDim.z;
    unsigned sum, cnt, mine, sp = 0u;
    for (;;) {
        sum = 0u; cnt = 0u; mine = 0u;
#pragma unroll
        for (unsigned j = 0; j < 16; ++j) { const unsigned c = xb_ld(&bar[XB_XCNT(j)]); sum += c; cnt += (c > 0u) ? 1u : 0u; mine = (j == x) ? c : mine; }
        if (sum == G) break;
        __builtin_amdgcn_s_sleep(1);
        if ((++sp & 255u) == 0u) { if (xb_ld(&bar[XB_TMO])) break; if (sp > XB_SPIN_CAP) { atomicAdd(&bar[XB_TMO], 1u); break; } }
    }
    nloc = mine > 0u ? mine : 1u; nx = cnt > 0u ? cnt : 1u;
}
__device__ __forceinline__ void xcd_barrier(const XcdBarrier& b) {
    asm volatile("s_waitcnt vmcnt(0)" ::: "memory");
    __syncthreads();
    if (threadIdx.x == 0) {
        unsigned* bar = b.bar;
        __builtin_amdgcn_s_waitcnt(0);
        unsigned nloc = b.st[0], nx = b.st[1];
        if (nloc == 0u) { xcd_barrier_complete(bar, b.x, nloc, nx); b.st[0] = nloc; b.st[1] = nx; }
        const unsigned old = xb_add(&bar[XB_XSUB(b.x)], 1u);
        const unsigned gen = old / nloc;
        if (old + 1u == (gen + 1u) * nloc) {
            __builtin_amdgcn_fence(__ATOMIC_RELEASE, "agent");
            asm volatile("s_waitcnt vmcnt(0)" ::: "memory");
            const unsigned og = xb_add(&bar[XB_TOP], 1u);
            const unsigned tg = og / nx;
            if (og + 1u == (tg + 1u) * nx) xb_add(&bar[XB_TOPGEN], 1u);
            else XB_SPIN(xb_ld(&bar[XB_TOPGEN]) == tg, bar);
            __builtin_amdgcn_fence(__ATOMIC_ACQUIRE, "agent");
            xb_add(&bar[XB_XGEN(b.x)], 1u);
            asm volatile("s_waitcnt vmcnt(0)" ::: "memory");
        } else {
            XB_SPIN(xb_ld(&bar[XB_XGEN(b.x)]) == gen, bar);
            __builtin_amdgcn_fence(__ATOMIC_ACQUIRE, "agent");
            asm volatile("s_waitcnt vmcnt(0)" ::: "memory");
        }
    }
    __syncthreads();
}

__device__ __forceinline__ void run_phase(PP P, int ph, LAS unsigned char* lds) {
    using namespace pg8;
#ifndef PMASK
#define PMASK 0xFFF
#endif
    if (ph == 0) { if (PMASK & 1) phase_prologue(P, lds); return; }
    if (ph == 1) { if (PMASK & 2) { prenorm_rows(P); filter_units(P, lds); } return; }
    const int l = (ph - 2) / 10, sp = (ph - 2) % 10;
    StaticOrder S;
    if (!((PMASK >> (2 + sp)) & 1)) return;
    switch (sp) {
    case 0: {
        Gemm g{(const bf16_t*)(P->ws + WS_HB), (const bf16_t*)(P->ws + WS_WIN + l * SZ_WIN), NTOK, NPROJ, D};
        S.init(NTOK, NPROJ, gridDim.x, BID(), 20, 32);
        Epi<EP_PROJ> E{(bf16_t*)(P->ws + WS_A), NPROJ, nullptr, nullptr, nullptr, (bf16_t*)(P->ws + WS_B)};
        gemm_phase(lds, g, S, E); break; }
    case 1: phase_mixers(P, l, lds); break;
    case 2: phase_combine(P, l); break;
    case 3: {
        Gemm ga{(const bf16_t*)(P->ws + WS_OA), (const bf16_t*)(P->ws + WS_WA + l * SZ_WBR), NTOK, D, DA};
        S.init(NTOK, D, gridDim.x, BID(), 0, 0);
        Epi<EP_BRA> Ea{(bf16_t*)(P->ws + WS_D), D, nullptr, (const bf16_t*)(P->ws + WS_A) + 8192, nullptr, nullptr};
        gemm_phase(lds, ga, S, Ea);
        Gemm gb{(const bf16_t*)(P->ws + WS_OB), (const bf16_t*)(P->ws + WS_WB + l * SZ_WBR), NTOK, D, DA};
        Epi<EP_BRB> Eb{(bf16_t*)(P->ws + WS_D + (size_t)NTOK * D * 2), D, nullptr, (const bf16_t*)(P->ws + WS_A) + 10240, (const bf16_t*)(P->ws + WS_D), nullptr};
        gemm_phase(lds, gb, S, Eb); break; }
    case 4: {
        Gemm g{(const bf16_t*)(P->ws + WS_D + (size_t)NTOK * D * 2), (const bf16_t*)(P->ws + WS_WOUT + l * SZ_WOUT), NTOK, D, D};
        S.init(NTOK, D, gridDim.x, BID(), 0, 0);
        Epi<EP_BF16> E{(bf16_t*)(P->ws + WS_B), D, nullptr, nullptr, nullptr, nullptr};
        gemm_phase(lds, g, S, E); break; }
    case 5: row_phase(P, l, (const bf16_t*)(P->ws + WS_B), 0); break;
    case 6: {
        Gemm g{(const bf16_t*)(P->ws + WS_HB), (const bf16_t*)(P->ws + WS_WUP + l * SZ_WUP), NTOK, NUP, D};
        S.init(NTOK, NUP, gridDim.x, BID(), 0, 0);
        Epi<EP_BF16> E{(bf16_t*)(P->ws + WS_A), NUP, nullptr, nullptr, nullptr, nullptr};
        gemm_phase(lds, g, S, E); break; }
    case 7: phase_ffnconv(P, l); break;
    case 8: {
        Gemm g{(const bf16_t*)(P->ws + WS_B), (const bf16_t*)(P->ws + WS_WDN + l * SZ_WDN), NTOK, D, DFF};
        S.init(NTOK, D, gridDim.x, BID(), 0, 0);
        Epi<EP_BF16> E{(bf16_t*)(P->ws + WS_D), D, nullptr, nullptr, nullptr, nullptr};
        gemm_phase(lds, g, S, E); break; }
    case 9: row_phase(P, l, (const bf16_t*)(P->ws + WS_D), 1); break;
    }
}

__global__ void __launch_bounds__(512, 2) fwd_kernel(Params Pv) {
    extern __shared__ __attribute__((aligned(16))) unsigned char shm[];
    PP P = (PP)__builtin_amdgcn_kernarg_segment_ptr();
    LAS unsigned char* lds = (LAS unsigned char*)shm;
    cg::grid_group grid = cg::this_grid();
    if (threadIdx.x < 4) ((LAS unsigned*)(lds + 131072))[threadIdx.x] = 0u;
    __syncthreads();
    (void)xcd_barrier_post((unsigned*)(P->ws + WS_BAR), (volatile LAS unsigned*)(lds + 131072));
#pragma unroll
    for (int ph = 0; ph < NPHASE; ++ph) {
        if (ph >= P->ph_lo && ph < P->ph_hi) {
            if (ph > P->ph_lo) { if (P->ph_hi > NPHASE) grid.sync(); else { XcdBarrier xb; xb.bar = (unsigned*)(P->ws + WS_BAR); xb.x = xb_xcc_id(); xb.st = (volatile LAS unsigned*)(lds + 131072); xcd_barrier(xb); } }
            run_phase(P, ph, lds);
#if DUPMASK
            if ((DUPMASK >> ph) & 1) { __syncthreads(); run_phase(P, ph, lds); }
#endif
        }
    }
}

extern "C" void kernel_launch(void* const* d_in, const int* in_sizes, int n_in, void* d_out, int out_size, void* d_ws, size_t ws_size, hipStream_t stream) {
    static int grid = 0;
    if (grid == 0) {
        if (n_in != 30 || ws_size < WS_END) { fprintf(stderr, "kernel_launch: expected 30 inputs and >= %zu bytes of workspace; got %d, %zu\n", (size_t)WS_END, n_in, ws_size); grid = -1; return; }
        int dev = 0, cus = 0, per_cu = 0;
        hipGetDevice(&dev); hipDeviceGetAttribute(&cus, hipDeviceAttributeMultiprocessorCount, dev);
        if (hipFuncSetAttribute((const void*)fwd_kernel, hipFuncAttributeMaxDynamicSharedMemorySize, LDS_BYTES) != hipSuccess) { fprintf(stderr, "kernel_launch: hipFuncSetAttribute failed\n"); grid = -1; return; }
        hipOccupancyMaxActiveBlocksPerMultiprocessor(&per_cu, (const void*)fwd_kernel, 512, LDS_BYTES);
        if (per_cu < 1) { fprintf(stderr, "kernel_launch: occupancy query reports %d blocks per CU\n", per_cu); per_cu = 1; }
        (void)hipGetLastError();
        grid = cus;
    }
    if (grid < 0) return;
    Params p{};
    for (int i = 0; i < 30; ++i) p.in[i] = (const float*)d_in[i];
    p.out = (float*)d_out; p.ws = (unsigned char*)d_ws;
    if (hipMemsetAsync((char*)d_ws + WS_BAR, 0, 16384, stream) != hipSuccess) { fprintf(stderr, "kernel_launch: memset of the barrier words failed\n"); return; }
#if PER_PHASE_LAUNCH
    for (int ph = 0; ph < NPHASE; ++ph) {
        p.ph_lo = ph; p.ph_hi = ph + 1;
        hipLaunchKernelGGL(fwd_kernel, dim3(grid), dim3(512), LDS_BYTES, stream, p);
    }
#else
    p.ph_lo = 0; p.ph_hi = NPHASE;
    void* args[] = {&p};
    hipError_t e = hipLaunchCooperativeKernel((const void*)fwd_kernel, dim3(grid), dim3(512), args, LDS_BYTES, stream);
    if (e != hipSuccess) fprintf(stderr, "cooperative launch failed: %s (grid %d)\n", hipGetErrorString(e), grid);
#endif
}
```

```cpp
#include <hip/hip_runtime.h>
#include <hip/hip_cooperative_groups.h>
#include <cstdio>
#include <cstdint>
namespace cg = cooperative_groups;

#ifndef PER_PHASE_LAUNCH
#define PER_PHASE_LAUNCH 0
#endif

#ifndef DUPMASK
#define DUPMASK 0
#endif
#define LAS __attribute__((address_space(3)))
typedef unsigned short bf16_t;
typedef short bf16x8 __attribute__((ext_vector_type(8)));
typedef float f32x4 __attribute__((ext_vector_type(4)));
typedef unsigned u32x4 __attribute__((ext_vector_type(4)));
typedef unsigned u32x2 __attribute__((ext_vector_type(2)));

constexpr int D = 2048, NTOK = 8192, NCTX = 4096, NPROJ = 12288, DA = 1024, DFF = 5632, NUP = 11264, NMOD = 12288;
constexpr float EPS = 1e-6f;
constexpr int LDS_BYTES = 131072 + 16;
constexpr int NPHASE = 22;

constexpr size_t SZ_WIN = (size_t)NPROJ * D * 2, SZ_WBR = (size_t)D * DA * 2, SZ_WOUT = (size_t)D * D * 2, SZ_WUP = (size_t)NUP * D * 2, SZ_WDN = (size_t)D * DFF * 2;
constexpr size_t WS_WIN = 0;
constexpr size_t WS_WA = WS_WIN + 2 * SZ_WIN;
constexpr size_t WS_WB = WS_WA + 2 * SZ_WBR;
constexpr size_t WS_WOUT = WS_WB + 2 * SZ_WBR;
constexpr size_t WS_WUP = WS_WOUT + 2 * SZ_WOUT;
constexpr size_t WS_WDN = WS_WUP + 2 * SZ_WUP;
constexpr size_t WS_MOD = WS_WDN + 2 * SZ_WDN;
constexpr size_t WS_H2 = WS_MOD + (size_t)2 * 5 * NMOD * 4;
constexpr size_t FILT_L = (size_t)2 * 1024 * 2048 + (size_t)2 * 1024 * 512;
constexpr size_t WS_FILT = WS_H2 + (size_t)2 * 1280 * 64 * 4;
constexpr size_t WS_HB = WS_FILT + 2 * FILT_L * 2;
constexpr size_t WS_OA = WS_HB + (size_t)NTOK * D * 2;
constexpr size_t WS_OB = WS_OA + (size_t)NTOK * DA * 2;
constexpr size_t WS_A = WS_OB + (size_t)NTOK * DA * 2;
constexpr size_t WS_B = WS_A + (size_t)NTOK * NPROJ * 2;
constexpr size_t SZ_HYT = (size_t)3072 * NTOK * 2;
constexpr size_t WS_D = WS_B + SZ_HYT + (size_t)2 * NTOK * DA * 4;
constexpr size_t WS_BAR = WS_D + (size_t)NTOK * D * 4;
constexpr size_t WS_END = WS_BAR + 16384;

struct Params {
    const float* in[30];
    float* out; unsigned char* ws;
    int ph_lo, ph_hi;
};
typedef const __attribute__((address_space(4))) Params* PP;
enum { I_XP = 0, I_XS, I_STATE, I_C, I_CCTX, I_WMOD, I_BMOD, I_GPREMIX, I_GPOSTMIX, I_GPREFFN, I_GPOSTFFN, I_WIN, I_LB, I_HNORM, I_HYCW, I_HYCB,
       I_HYW1, I_HYB1, I_HYW2, I_HYB2, I_HYW3, I_HYDEC, I_HYBIAS, I_WA, I_WB, I_WOUT, I_WUP, I_FCW, I_FCB, I_WDN };

__device__ __forceinline__ float bf2f(unsigned b) { return __uint_as_float(b << 16); }
__device__ __forceinline__ float bflo(unsigned w) { return __uint_as_float(w << 16); }
__device__ __forceinline__ float bfhi(unsigned w) { return __uint_as_float(w & 0xffff0000u); }
__device__ __forceinline__ unsigned pk2(float lo, float hi) { unsigned r; asm("v_cvt_pk_bf16_f32 %0, %1, %2" : "=v"(r) : "v"(lo), "v"(hi)); return r; }
__device__ __forceinline__ bf16_t f2bf(float f) { return (bf16_t)(pk2(f, 0.f) & 0xffffu); }
__device__ __forceinline__ float wave_sum(float v) {
#pragma unroll
    for (int o = 1; o < 64; o <<= 1) v += __shfl_xor(v, o);
    return v;
}
#define LBAR() do { asm volatile("s_waitcnt lgkmcnt(0)" ::: "memory"); __builtin_amdgcn_s_barrier(); asm volatile("" ::: "memory"); } while (0)
__device__ __forceinline__ int TID() { int t = threadIdx.x; asm volatile("" : "+v"(t)); return t; }
__device__ __forceinline__ int BID() { int b = blockIdx.x; asm volatile("" : "+s"(b)); return b; }
__device__ __forceinline__ float sigmoidf_(float z) { return __builtin_amdgcn_rcpf(1.f + __expf(-z)); }
__device__ __forceinline__ float siluf_(float z) { return z * __builtin_amdgcn_rcpf(1.f + __expf(-z)); }

namespace pg8 {
constexpr int BM = 256, BK = 64, HALF = 128, HTB = HALF * BK * 2, STAGE_BYTES = 8 * HTB, NXCD = 8, WGM = 8;
__host__ __device__ __forceinline__ int lds_byte(int r, int c) { const int st = (r >> 4) * 2 + (c >> 5), rr = r & 15, cc = c & 31, ob = rr * 64 + cc * 2; return st * 1024 + (ob ^ (((ob >> 9) & 1) << 5)); }
__host__ __device__ __forceinline__ void stage_rc(int b, int& R, int& C) { const int st = b / 1024, sb = b % 1024, swz = sb ^ (((sb >> 9) & 1) << 5); R = (st >> 1) * 16 + swz / 64; C = (st & 1) * 32 + (swz % 64) / 2; }
__host__ __device__ __forceinline__ int perm32(int rho) { const int n = rho >> 4, i = rho & 15; return 8 * (i >> 2) + 4 * n + (i & 3); }

struct Unit { int pm, pn; };
struct Gemm { const bf16_t* A; const bf16_t* Bt; int M, N, K; };

struct StaticOrder {
    int nM, nN, nwg, G, c, sw_lo, sw_hi;
    __device__ void init(int M, int N, int G_, int c_, int swlo, int swhi) { nM = M / BM; nN = N / BM; nwg = nM * nN; G = G_; c = c_; sw_lo = swlo; sw_hi = swhi; }
    __device__ bool next(int i, Unit& u) const {
        const long L = (long)i * G + c; if (L >= nwg) return false;
        int wgid = (int)L; { const int q = nwg / NXCD, r = nwg % NXCD, xcd = wgid % NXCD, off = wgid / NXCD; wgid = (xcd < r ? xcd * (q + 1) : r * (q + 1) + (xcd - r) * q) + off; }
        const int nig = WGM * nN, gid = wgid / nig, fm = gid * WGM, gsz = (nM - fm) < WGM ? (nM - fm) : WGM;
        u.pm = fm + ((wgid % nig) % gsz); u.pn = (wgid % nig) / gsz; return true;
    }
    __device__ __forceinline__ bool is_sw(const Unit& u) const { return u.pn >= sw_lo && u.pn < sw_hi; }
};

enum { EP_PROJ = 0, EP_BF16 = 1, EP_BRA = 2, EP_BRB = 3, EP_F32 = 4 };
template <int MODE> struct Epi {
    static constexpr bool PERM = (MODE != EP_F32);
    bf16_t* O; int ldc; float* C; const bf16_t* G; const bf16_t* T; bf16_t* HYT;
    __device__ __forceinline__ void operator()(const f32x4 (&acc)[2][2][4][2], const Unit& u, bool sw, int wr, int wc, int fr, int fq) const {
        if constexpr (MODE == EP_F32) {
            const int row0 = u.pm * BM + wr * 64 + fr, col0 = u.pn * BM + wc * 32 + 4 * fq;
#pragma unroll
            for (int ai = 0; ai < 2; ++ai)
#pragma unroll
                for (int m = 0; m < 4; ++m) { float* rowp = C + (size_t)(row0 + ai * HALF + m * 16) * ldc + col0;
#pragma unroll
                    for (int bj = 0; bj < 2; ++bj)
#pragma unroll
                        for (int n = 0; n < 2; ++n) *(f32x4*)(rowp + bj * HALF + n * 16) = acc[ai][bj][m][n]; }
        } else {
            if (MODE == EP_PROJ && sw) {
                const int ch0 = (u.pn - 20) * BM + wr * 64 + fr, tok0 = u.pm * BM + wc * 32 + 8 * fq;
#pragma unroll
                for (int ai = 0; ai < 2; ++ai)
#pragma unroll
                    for (int m = 0; m < 4; ++m) { bf16_t* rowp = HYT + (size_t)(ch0 + ai * HALF + m * 16) * NTOK + tok0;
#pragma unroll
                        for (int bj = 0; bj < 2; ++bj) { const f32x4 v0 = acc[ai][bj][m][0], v1 = acc[ai][bj][m][1];
                            u32x4 o; o.x = pk2(v0[0], v0[1]); o.y = pk2(v0[2], v0[3]); o.z = pk2(v1[0], v1[1]); o.w = pk2(v1[2], v1[3]);
                            *(u32x4*)(rowp + bj * HALF) = o; } }
                return;
            }
            const int row0 = u.pm * BM + wr * 64 + fr, col0 = u.pn * BM + wc * 32 + 8 * fq;
#pragma unroll
            for (int ai = 0; ai < 2; ++ai)
#pragma unroll
                for (int m = 0; m < 4; ++m) { const size_t r = (size_t)(row0 + ai * HALF + m * 16);
#pragma unroll
                    for (int bj = 0; bj < 2; ++bj) { f32x4 v0 = acc[ai][bj][m][0], v1 = acc[ai][bj][m][1]; const int cc = col0 + bj * HALF;
                        if constexpr (MODE == EP_BRA || MODE == EP_BRB) {
                            const u32x4 g = *(const u32x4*)(G + r * NPROJ + cc);
                            v0[0] *= sigmoidf_(bflo(g.x)); v0[1] *= sigmoidf_(bfhi(g.x)); v0[2] *= sigmoidf_(bflo(g.y)); v0[3] *= sigmoidf_(bfhi(g.y));
                            v1[0] *= sigmoidf_(bflo(g.z)); v1[1] *= sigmoidf_(bfhi(g.z)); v1[2] *= sigmoidf_(bflo(g.w)); v1[3] *= sigmoidf_(bfhi(g.w));
                        }
                        if constexpr (MODE == EP_BRB) {
                            const u32x4 t = *(const u32x4*)(T + r * ldc + cc);
                            v0[0] += bflo(t.x); v0[1] += bfhi(t.x); v0[2] += bflo(t.y); v0[3] += bfhi(t.y);
                            v1[0] += bflo(t.z); v1[1] += bfhi(t.z); v1[2] += bflo(t.w); v1[3] += bfhi(t.w);
                        }
                        u32x4 o; o.x = pk2(v0[0], v0[1]); o.y = pk2(v0[2], v0[3]); o.z = pk2(v1[0], v1[1]); o.w = pk2(v1[2], v1[3]);
                        *(u32x4*)(O + r * ldc + cc) = o; } }
        }
    }
};

#ifndef GEMM_SP2
#define GEMM_SP2 1
#endif
#ifndef GEMM_ALIGN
#define GEMM_ALIGN 1
#endif
template <class EpiT, bool ALIGN_EPI = (GEMM_ALIGN != 0), bool SP2 = (GEMM_SP2 != 0)>
__device__ __forceinline__ void gemm_phase(LAS unsigned char* lds, const Gemm g, const StaticOrder& S, const EpiT& E) {
    const int tid = TID(), wid = __builtin_amdgcn_readfirstlane(tid >> 6), lane = tid & 63, wr = wid >> 2, wc = wid & 3, fr = lane & 15, fq = lane >> 4;
    const int K = g.K, nt = K / BK;
    unsigned voffA[2], voffB[2];
#pragma unroll
    for (int i = 0; i < 2; ++i) { int R, C; stage_rc(tid * 16 + i * 8192, R, C); const int Rb = EpiT::PERM ? ((R & ~31) + perm32(R & 31)) : R;
        voffA[i] = (unsigned)(R * K + C) * 2u; voffB[i] = (unsigned)(Rb * K + C) * 2u; }
    const size_t kstep = (size_t)(BK * 2);
    const size_t hstep = (size_t)HALF * K * 2;
    const size_t tstep = 2 * hstep;
    const unsigned ldsw = (unsigned)wid * 1024u;
    const int aoff = lds_byte(wr * 64 + fr, fq * 8), boff = lds_byte(wc * 32 + fr, fq * 8);
#define PG8_SA(b, h) (((b) * 2 + (h)) * HTB)
#define PG8_SB(b, h) ((4 + (b) * 2 + (h)) * HTB)
#define PG8_STAGE(bufoff, gbase, voff) do { _Pragma("unroll") for (int _i = 0; _i < 2; ++_i) \
        __builtin_amdgcn_global_load_lds((const unsigned*)((const char*)(gbase) + (voff)[_i]), (LAS unsigned*)(lds + (bufoff) + ldsw + _i * 8192), 16, 0, 0); } while (0)
#define PG8_LDA(dst, b, h) do { _Pragma("unroll") for (int m = 0; m < 4; ++m) _Pragma("unroll") for (int k = 0; k < 2; ++k) dst[m][k] = *(const LAS bf16x8*)(lds + PG8_SA(b, h) + aoff + m * 2048 + k * 1024); } while (0)
#define PG8_LDB(dst, b, h) do { _Pragma("unroll") for (int n = 0; n < 2; ++n) _Pragma("unroll") for (int k = 0; k < 2; ++k) dst[n][k] = *(const LAS bf16x8*)(lds + PG8_SB(b, h) + boff + n * 2048 + k * 1024); } while (0)
#define PG8_MMA(ai, bj, At, Bt) do { __builtin_amdgcn_s_setprio(1); _Pragma("unroll") for (int m = 0; m < 4; ++m) _Pragma("unroll") for (int n = 0; n < 2; ++n) _Pragma("unroll") for (int k = 0; k < 2; ++k) \
        acc[ai][bj][m][n] = __builtin_amdgcn_mfma_f32_16x16x32_bf16(Bt[n][k], At[m][k], acc[ai][bj][m][n], 0, 0, 0); __builtin_amdgcn_s_setprio(0); } while (0)
#define PG8_WAIT_V(n) asm volatile("s_waitcnt vmcnt(" #n ")" ::: "memory")
#define PG8_WAIT_L(n) asm volatile("s_waitcnt lgkmcnt(" #n ")" ::: "memory")
#define PG8_BAR __builtin_amdgcn_s_barrier()
#define PG8_SCHED __builtin_amdgcn_sched_barrier(0)
    Unit cur, nxt; int ui = 0;
    if (!S.next(0, cur)) return;
    f32x4 acc[2][2][4][2];
#pragma unroll
    for (int a = 0; a < 2; ++a)
#pragma unroll
        for (int b = 0; b < 2; ++b)
#pragma unroll
            for (int m = 0; m < 4; ++m)
#pragma unroll
                for (int n = 0; n < 2; ++n) acc[a][b][m][n] = (f32x4){0.f, 0.f, 0.f, 0.f};
    bf16x8 At[4][2], B0[2][2], B1[2][2];
    bool csw = S.is_sw(cur);
    const char* cA = csw ? (const char*)g.Bt + (size_t)cur.pn * tstep : (const char*)g.A + (size_t)cur.pm * tstep;
    const char* cB = csw ? (const char*)g.A + (size_t)cur.pm * tstep : (const char*)g.Bt + (size_t)cur.pn * tstep;
    if constexpr (SP2) {
        PG8_STAGE(PG8_SB(0, 0), cB, voffB); PG8_STAGE(PG8_SB(0, 1), cB + hstep, voffB); PG8_STAGE(PG8_SA(0, 0), cA, voffA); PG8_STAGE(PG8_SA(0, 1), cA + hstep, voffA);
        if (wr == 1) PG8_BAR;
        PG8_WAIT_V(2); PG8_BAR;
        PG8_STAGE(PG8_SB(1, 0), cB + kstep, voffB); PG8_STAGE(PG8_SA(1, 0), cA + kstep, voffA); PG8_STAGE(PG8_SB(1, 1), cB + hstep + kstep, voffB);
        PG8_WAIT_V(6); PG8_BAR;
    } else {
    PG8_STAGE(PG8_SB(0, 0), cB, voffB); PG8_STAGE(PG8_SA(0, 0), cA, voffA); PG8_STAGE(PG8_SB(0, 1), cB + hstep, voffB); PG8_STAGE(PG8_SA(0, 1), cA + hstep, voffA);
    if (wr == 1) PG8_BAR;
    PG8_WAIT_V(4); PG8_BAR;
    PG8_STAGE(PG8_SB(1, 0), cB + kstep, voffB); PG8_STAGE(PG8_SA(1, 0), cA + kstep, voffA); PG8_STAGE(PG8_SB(1, 1), cB + hstep + kstep, voffB);
    PG8_WAIT_V(6); PG8_BAR;
    }
    for (;;) {
        const bool has_next = S.next(ui + 1, nxt);
        const bool nsw = has_next ? S.is_sw(nxt) : false;
        const char* nA = has_next ? (nsw ? (const char*)g.Bt + (size_t)nxt.pn * tstep : (const char*)g.A + (size_t)nxt.pm * tstep) : cA;
        const char* nB = has_next ? (nsw ? (const char*)g.A + (size_t)nxt.pm * tstep : (const char*)g.Bt + (size_t)nxt.pn * tstep) : cB;
        for (int t = 0; t < nt; t += 2) {
            const bool last = (t == nt - 2);
            const char* a1 = cA + (size_t)(t + 1) * kstep;
            const char* a2 = last ? nA : cA + (size_t)(t + 2) * kstep; const char* b2 = last ? nB : cB + (size_t)(t + 2) * kstep;
            const char* a3 = a2 + kstep; const char* b3 = b2 + kstep;
            if constexpr (SP2) {
            PG8_LDB(B0, 0, 0); PG8_LDB(B1, 0, 1); PG8_SCHED; PG8_LDA(At, 0, 0); PG8_STAGE(PG8_SA(1, 1), a1 + hstep, voffA);
            PG8_WAIT_V(8); PG8_WAIT_L(0); PG8_BAR; PG8_MMA(0, 0, At, B0); PG8_MMA(0, 1, At, B1); PG8_BAR; PG8_SCHED;
            PG8_LDA(At, 0, 1); PG8_STAGE(PG8_SB(0, 0), b2, voffB); PG8_STAGE(PG8_SB(0, 1), b2 + hstep, voffB); PG8_STAGE(PG8_SA(0, 0), a2, voffA);
            PG8_WAIT_V(8); PG8_WAIT_L(0); PG8_BAR; PG8_MMA(1, 0, At, B0); PG8_MMA(1, 1, At, B1); PG8_BAR; PG8_SCHED;
            PG8_LDB(B0, 1, 0); PG8_LDB(B1, 1, 1); PG8_SCHED; PG8_LDA(At, 1, 0); PG8_STAGE(PG8_SA(0, 1), a2 + hstep, voffA);
            PG8_WAIT_V(8); PG8_WAIT_L(0); PG8_BAR; PG8_MMA(0, 0, At, B0); PG8_MMA(0, 1, At, B1); PG8_BAR; PG8_SCHED;
            PG8_LDA(At, 1, 1); PG8_STAGE(PG8_SB(1, 0), b3, voffB); PG8_STAGE(PG8_SB(1, 1), b3 + hstep, voffB); PG8_STAGE(PG8_SA(1, 0), a3, voffA);
            PG8_WAIT_V(8); PG8_WAIT_L(0); PG8_BAR; PG8_MMA(1, 0, At, B0); PG8_MMA(1, 1, At, B1); PG8_BAR; PG8_SCHED;
            } else {
            PG8_LDB(B0, 0, 0); PG8_SCHED; PG8_LDA(At, 0, 0); PG8_STAGE(PG8_SA(1, 1), a1 + hstep, voffA);
            PG8_WAIT_L(8); PG8_BAR; PG8_WAIT_L(0); PG8_MMA(0, 0, At, B0); PG8_BAR; PG8_SCHED;
            PG8_LDB(B1, 0, 1); PG8_STAGE(PG8_SB(0, 0), b2, voffB);
            PG8_BAR; PG8_WAIT_L(0); PG8_MMA(0, 1, At, B1); PG8_BAR;
            PG8_LDA(At, 0, 1); PG8_STAGE(PG8_SA(0, 0), a2, voffA);
            PG8_BAR; PG8_WAIT_L(0); PG8_MMA(1, 0, At, B0); PG8_BAR; PG8_SCHED;
            PG8_STAGE(PG8_SB(0, 1), b2 + hstep, voffB);
            PG8_WAIT_V(6); PG8_BAR; PG8_MMA(1, 1, At, B1); PG8_BAR;
            PG8_LDB(B0, 1, 0); PG8_SCHED; PG8_LDA(At, 1, 0); PG8_STAGE(PG8_SA(0, 1), a2 + hstep, voffA);
            PG8_WAIT_L(8); PG8_BAR; PG8_WAIT_L(0); PG8_MMA(0, 0, At, B0); PG8_BAR; PG8_SCHED;
            PG8_LDB(B1, 1, 1); PG8_STAGE(PG8_SB(1, 0), b3, voffB);
            PG8_BAR; PG8_WAIT_L(0); PG8_MMA(0, 1, At, B1); PG8_BAR;
            PG8_LDA(At, 1, 1); PG8_STAGE(PG8_SA(1, 0), a3, voffA);
            PG8_BAR; PG8_WAIT_L(0); PG8_MMA(1, 0, At, B0); PG8_BAR; PG8_SCHED;
            PG8_STAGE(PG8_SB(1, 1), b3 + hstep, voffB);
            PG8_WAIT_V(6); PG8_BAR; PG8_MMA(1, 1, At, B1); PG8_BAR;
            }
        }
        if constexpr (ALIGN_EPI) { if (wr == 0) PG8_BAR; }
        E(acc, cur, csw, wr, wc, fr, fq);
        if (!has_next) break;
#pragma unroll
        for (int a = 0; a < 2; ++a)
#pragma unroll
            for (int b = 0; b < 2; ++b)
#pragma unroll
                for (int m = 0; m < 4; ++m)
#pragma unroll
                    for (int n = 0; n < 2; ++n) acc[a][b][m][n] = (f32x4){0.f, 0.f, 0.f, 0.f};
        cur = nxt; cA = nA; cB = nB; csw = nsw; ++ui;
        if constexpr (ALIGN_EPI) { if (wr == 1) PG8_BAR; }
    }
    PG8_WAIT_V(0);
    if constexpr (!ALIGN_EPI) { if (wr == 0) PG8_BAR; }
    PG8_BAR;
#undef PG8_SA
#undef PG8_SB
#undef PG8_STAGE
#undef PG8_LDA
#undef PG8_LDB
#undef PG8_MMA
#undef PG8_WAIT_V
#undef PG8_WAIT_L
#undef PG8_BAR
#undef PG8_SCHED
}
}

__device__ __forceinline__ void transpose_item(const float* __restrict__ W, int K, int N, bf16_t* __restrict__ WT, LAS float* scr, int item, int lane) {
    const int nblk = N >> 5, kb = item / nblk, nb = item - kb * nblk, k0 = kb * 64, n0 = nb * 32;
    float v[32];
#pragma unroll
    for (int i = 0; i < 32; ++i) { const int kk = 2 * i + (lane >> 5); v[i] = W[(size_t)(k0 + kk) * N + n0 + (lane & 31)]; }
#pragma unroll
    for (int i = 0; i < 32; ++i) { const int kk = 2 * i + (lane >> 5); scr[kk * 33 + (lane & 31)] = v[i]; }
    asm volatile("s_waitcnt lgkmcnt(0)" ::: "memory");
    const int c = lane & 7;
#pragma unroll
    for (int j = 0; j < 4; ++j) { const int n = (lane >> 3) + 8 * j; const LAS float* s = scr + (8 * c) * 33 + n;
        u32x4 o; o.x = pk2(s[0 * 33], s[1 * 33]); o.y = pk2(s[2 * 33], s[3 * 33]); o.z = pk2(s[4 * 33], s[5 * 33]); o.w = pk2(s[6 * 33], s[7 * 33]);
        *(u32x4*)(WT + (size_t)(n0 + n) * K + k0 + 8 * c) = o; }
    asm volatile("s_waitcnt lgkmcnt(0)" ::: "memory");
}

__device__ __forceinline__ void phase_prologue(PP P, LAS unsigned char* lds) {
    const int tid = TID(), lane = tid & 63, wave = tid >> 6;
    {
        LAS float* s = (LAS float*)lds;
        LAS float* red = (LAS float*)(lds + 40960);
        for (int i = tid; i < 5 * D; i += 512) { const int r = i / D, k = i - r * D; const float v = (r < 4) ? P->in[I_C][r * D + k] : P->in[I_CCTX][k]; s[i] = siluf_(v); }
        __syncthreads();
        for (int it = BID(); it < 256; it += gridDim.x) {
            const int l = it >> 7, col0 = (it & 127) * 96;
            const int cgp = tid % 24, kg = tid / 24;
            float acc[5][4];
#pragma unroll
            for (int r = 0; r < 5; ++r)
#pragma unroll
                for (int i = 0; i < 4; ++i) acc[r][i] = 0.f;
            if (kg < 21) {
                const float* wp = P->in[I_WMOD] + (size_t)l * D * NMOD + col0 + 4 * cgp;
#pragma unroll 7
                for (int k = kg; k < D; k += 21) {
                    const f32x4 w = *(const f32x4*)(wp + (size_t)k * NMOD);
#pragma unroll
                    for (int r = 0; r < 5; ++r) { const float sv = s[r * D + k]; acc[r][0] += sv * w[0]; acc[r][1] += sv * w[1]; acc[r][2] += sv * w[2]; acc[r][3] += sv * w[3]; }
                }
#pragma unroll
                for (int r = 0; r < 5; ++r)
#pragma unroll
                    for (int i = 0; i < 4; ++i) red[(kg * 24 + cgp) * 20 + r * 4 + i] = acc[r][i];
            }
            __syncthreads();
            if (tid < 480) {
                const int cg2 = tid / 20, ri = tid % 20, r = ri >> 2, i = ri & 3;
                float sum = 0.f;
                for (int k2 = 0; k2 < 21; ++k2) sum += red[(k2 * 24 + cg2) * 20 + ri];
                const int col = col0 + 4 * cg2 + i;
                ((float*)(P->ws + WS_MOD))[((size_t)l * 5 + r) * NMOD + col] = sum + P->in[I_BMOD][l * NMOD + col];
            }
            __syncthreads();
        }
    }
    {
        const int gw = BID() * 8 + wave, NGW = gridDim.x * 8;
        for (int idx = gw; idx < 2 * 1280; idx += NGW) {
            const int l = idx / 1280, rr = idx - l * 1280; const int L = rr < 1024 ? 1024 : 256; const int t = rr < 1024 ? rr : rr - 1024;
            const float tf = (float)t, t01 = tf / (float)(L - 1);
            float feat = 0.f;
            if (lane == 0) feat = t01;
            else if (lane <= 32) { const int bi = (lane - 1) & 15; const float band = 1e-4f + (float)bi * ((15.0f - 1e-4f) / 15.0f);
                const float ang = (6.283185307179586f / (float)L) * tf * band; feat = (lane <= 16) ? cosf(ang) : -sinf(ang); }
            const float* w1 = P->in[I_HYW1] + l * 33 * 64; const float* w2 = P->in[I_HYW2] + l * 64 * 64;
            float a1 = P->in[I_HYB1][l * 64 + lane];
            for (int i = 0; i < 33; ++i) a1 += __shfl(feat, i) * w1[i * 64 + lane];
            const float h1 = sinf(a1);
            float a2 = P->in[I_HYB2][l * 64 + lane];
            for (int i = 0; i < 64; ++i) a2 += __shfl(h1, i) * w2[i * 64 + lane];
            ((float*)(P->ws + WS_H2))[(size_t)idx * 64 + lane] = sinf(a2);
        }
    }
    {
        LAS float* scr = (LAS float*)(lds + wave * 8448);
        const int gw = BID() * 8 + wave, NGW = gridDim.x * 8;
        constexpr int I_IN = 32 * 384, I_BR = 16 * 64, I_OUT = 32 * 64, I_UP = 32 * 352, I_DN = 88 * 64, I_LAYER = I_IN + 2 * I_BR + I_OUT + I_UP + I_DN;
        for (int it = gw; it < 2 * I_LAYER; it += NGW) {
            const int l = it / I_LAYER; int r = it - l * I_LAYER;
            if (r < I_IN) { transpose_item(P->in[I_WIN] + (size_t)l * D * NPROJ, D, NPROJ, (bf16_t*)(P->ws + WS_WIN + l * SZ_WIN), scr, r, lane); continue; } r -= I_IN;
            if (r < I_BR) { transpose_item(P->in[I_WA] + (size_t)l * DA * D, DA, D, (bf16_t*)(P->ws + WS_WA + l * SZ_WBR), scr, r, lane); continue; } r -= I_BR;
            if (r < I_BR) { transpose_item(P->in[I_WB] + (size_t)l * DA * D, DA, D, (bf16_t*)(P->ws + WS_WB + l * SZ_WBR), scr, r, lane); continue; } r -= I_BR;
            if (r < I_OUT) { transpose_item(P->in[I_WOUT] + (size_t)l * D * D, D, D, (bf16_t*)(P->ws + WS_WOUT + l * SZ_WOUT), scr, r, lane); continue; } r -= I_OUT;
            if (r < I_UP) { transpose_item(P->in[I_WUP] + (size_t)l * D * NUP, D, NUP, (bf16_t*)(P->ws + WS_WUP + l * SZ_WUP), scr, r, lane); continue; } r -= I_UP;
            transpose_item(P->in[I_WDN] + (size_t)l * DFF * D, DFF, D, (bf16_t*)(P->ws + WS_WDN + l * SZ_WDN), scr, r, lane);
        }
    }
}

__device__ __forceinline__ void prenorm_rows(PP P) {
    const int tid_ = TID(), lane = tid_ & 63, gw = BID() * 8 + (tid_ >> 6), NGW = gridDim.x * 8;
    const float* mod = (const float*)(P->ws + WS_MOD);
    bf16_t* HB = (bf16_t*)(P->ws + WS_HB);
    for (int row = gw; row < NTOK; row += NGW) {
        const float* xr = (row < NCTX) ? P->in[I_XP] + (size_t)row * D : P->in[I_XS] + (size_t)(row - NCTX) * D;
        const int mr = (row < NCTX) ? 4 : ((row - NCTX) >> 10);
        const float* md = mod + (size_t)mr * NMOD;
        f32x4 v[8]; float ss = 0.f;
#pragma unroll
        for (int j = 0; j < 8; ++j) { v[j] = *(const f32x4*)(xr + 4 * lane + 256 * j); ss += v[j][0] * v[j][0] + v[j][1] * v[j][1] + v[j][2] * v[j][2] + v[j][3] * v[j][3]; }
        const float r = rsqrtf(wave_sum(ss) * (1.f / D) + EPS);
#pragma unroll
        for (int j = 0; j < 8; ++j) { const int c = 4 * lane + 256 * j;
            const f32x4 g = *(const f32x4*)(P->in[I_GPREMIX] + c), sh = *(const f32x4*)(md + c), sc = *(const f32x4*)(md + D + c);
            u32x2 o; o.x = pk2(v[j][0] * r * g[0] * (1.f + sc[0]) + sh[0], v[j][1] * r * g[1] * (1.f + sc[1]) + sh[1]);
            o.y = pk2(v[j][2] * r * g[2] * (1.f + sc[2]) + sh[2], v[j][3] * r * g[3] * (1.f + sc[3]) + sh[3]);
            *(u32x2*)(HB + (size_t)row * D + c) = o; }
    }
}
__device__ __forceinline__ void row_phase(PP P, int l, const bf16_t* Y, int which  ) {
    const int tid_ = TID(), lane = tid_ & 63, gw = BID() * 8 + (tid_ >> 6), NGW = gridDim.x * 8;
    const float* mod = (const float*)(P->ws + WS_MOD);
    bf16_t* HB = (bf16_t*)(P->ws + WS_HB);
    const float* gpost = (which == 0 ? P->in[I_GPOSTMIX] : P->in[I_GPOSTFFN]) + l * D;
    const bool do_h = (which == 0) || (l + 1 < 2);
    const int ln = (which == 0) ? l : l + 1;
    const float* gpre = (which == 0 ? P->in[I_GPREFFN] : P->in[I_GPREMIX]) + (do_h ? ln : 0) * D;
    for (int row = gw; row < NTOK; row += NGW) {
        const int mr = (row < NCTX) ? 4 : ((row - NCTX) >> 10);
        const float* md = mod + ((size_t)l * 5 + mr) * NMOD;
        const float* gt = md + (which == 0 ? 2 : 5) * D;
        const float* mdn = mod + ((size_t)(do_h ? ln : 0) * 5 + mr) * NMOD + (which == 0 ? 3 * D : 0);
        const float* xo = (l == 0 && which == 0) ? ((row < NCTX) ? P->in[I_XP] + (size_t)row * D : P->in[I_XS] + (size_t)(row - NCTX) * D) : P->out + (size_t)row * D;
        const bf16_t* yr = Y + (size_t)row * D;
        f32x4 y[8], x[8]; float ss = 0.f;
#pragma unroll
        for (int j = 0; j < 8; ++j) { { const u32x2 yb = *(const u32x2*)(yr + 4 * lane + 256 * j); y[j][0] = bflo(yb.x); y[j][1] = bfhi(yb.x); y[j][2] = bflo(yb.y); y[j][3] = bfhi(yb.y); } x[j] = *(const f32x4*)(xo + 4 * lane + 256 * j);
            ss += y[j][0] * y[j][0] + y[j][1] * y[j][1] + y[j][2] * y[j][2] + y[j][3] * y[j][3]; }
        const float r1 = rsqrtf(wave_sum(ss) * (1.f / D) + EPS);
        float ss2 = 0.f;
#pragma unroll
        for (int j = 0; j < 8; ++j) { const int c = 4 * lane + 256 * j; const f32x4 g = *(const f32x4*)(gpost + c), t = *(const f32x4*)(gt + c);
            x[j][0] += t[0] * (y[j][0] * r1 * g[0]); x[j][1] += t[1] * (y[j][1] * r1 * g[1]); x[j][2] += t[2] * (y[j][2] * r1 * g[2]); x[j][3] += t[3] * (y[j][3] * r1 * g[3]);
            *(f32x4*)(P->out + (size_t)row * D + c) = x[j];
            ss2 += x[j][0] * x[j][0] + x[j][1] * x[j][1] + x[j][2] * x[j][2] + x[j][3] * x[j][3]; }
        if (do_h) {
            const float r2 = rsqrtf(wave_sum(ss2) * (1.f / D) + EPS);
#pragma unroll
            for (int j = 0; j < 8; ++j) { const int c = 4 * lane + 256 * j;
                const f32x4 g = *(const f32x4*)(gpre + c), sh = *(const f32x4*)(mdn + c), sc = *(const f32x4*)(mdn + D + c);
                u32x2 o; o.x = pk2(x[j][0] * r2 * g[0] * (1.f + sc[0]) + sh[0], x[j][1] * r2 * g[1] * (1.f + sc[1]) + sh[1]);
                o.y = pk2(x[j][2] * r2 * g[2] * (1.f + sc[2]) + sh[2], x[j][3] * r2 * g[3] * (1.f + sc[3]) + sh[3]);
                *(u32x2*)(HB + (size_t)row * D + c) = o; }
        }
    }
}

__device__ __forceinline__ void filter_units(PP P, LAS unsigned char* lds) {
    const int tid = TID(), lane = tid & 63, wave = tid >> 6;
    LAS float* h3 = (LAS float*)lds;
    for (int u = BID(); u < 512; u += gridDim.x) {
        const int l = u >> 8, c0 = (u & 255) * 4;
        const float* w3 = P->in[I_HYW3] + (size_t)l * 64 * 4096;
        const int fr = lane & 15, fq = lane >> 4;
        const int qcol = (fr >> 3) * 2048 + ((fr >> 2) & 1) * 1024 + c0 + (fr & 3);
        const float dcq = fabsf(P->in[I_HYDEC][(l * 2 + (fr >> 3)) * 1024 + c0 + (fr & 3)]);
        bf16x8 bh[2], bl[2];
#pragma unroll
        for (int kk = 0; kk < 2; ++kk) {
            float wv[8];
#pragma unroll
            for (int j = 0; j < 8; ++j) wv[j] = w3[(size_t)(32 * kk + 8 * fq + j) * 4096 + qcol];
            u32x4 hi, lo;
            hi.x = pk2(wv[0], wv[1]); hi.y = pk2(wv[2], wv[3]); hi.z = pk2(wv[4], wv[5]); hi.w = pk2(wv[6], wv[7]);
            lo.x = pk2(wv[0] - bflo(hi.x), wv[1] - bfhi(hi.x)); lo.y = pk2(wv[2] - bflo(hi.y), wv[3] - bfhi(hi.y));
            lo.z = pk2(wv[4] - bflo(hi.z), wv[5] - bfhi(hi.z)); lo.w = pk2(wv[6] - bflo(hi.w), wv[7] - bfhi(hi.w));
            bh[kk] = __builtin_bit_cast(bf16x8, hi); bl[kk] = __builtin_bit_cast(bf16x8, lo);
        }
        for (int lv = 0; lv < 2; ++lv) {
            const int L = lv == 0 ? 1024 : 256; const int rowoff = lv == 0 ? 0 : 1024;
            const float invL1 = 1.f / (float)(L - 1);
            for (int tb = wave; tb < (L >> 4); tb += 8) {
                const int t0 = tb * 16;
                const float* hr = (const float*)(P->ws + WS_H2) + ((size_t)l * 1280 + rowoff + t0 + fr) * 64 + 8 * fq;
                f32x4 acc = (f32x4){0.f, 0.f, 0.f, 0.f};
#pragma unroll
                for (int kk = 0; kk < 2; ++kk) {
                    const f32x4 h0 = *(const f32x4*)(hr + 32 * kk), h1 = *(const f32x4*)(hr + 32 * kk + 4);
                    u32x4 hi, lo;
                    hi.x = pk2(h0[0], h0[1]); hi.y = pk2(h0[2], h0[3]); hi.z = pk2(h1[0], h1[1]); hi.w = pk2(h1[2], h1[3]);
                    lo.x = pk2(h0[0] - bflo(hi.x), h0[1] - bfhi(hi.x)); lo.y = pk2(h0[2] - bflo(hi.y), h0[3] - bfhi(hi.y));
                    lo.z = pk2(h1[0] - bflo(hi.z), h1[1] - bfhi(hi.z)); lo.w = pk2(h1[2] - bflo(hi.w), h1[3] - bfhi(hi.w));
                    const bf16x8 ah = __builtin_bit_cast(bf16x8, hi), al = __builtin_bit_cast(bf16x8, lo);
                    acc = __builtin_amdgcn_mfma_f32_16x16x32_bf16(ah, bh[kk], acc, 0, 0, 0);
                    acc = __builtin_amdgcn_mfma_f32_16x16x32_bf16(ah, bl[kk], acc, 0, 0, 0);
                    acc = __builtin_amdgcn_mfma_f32_16x16x32_bf16(al, bh[kk], acc, 0, 0, 0);
                }
#pragma unroll
                for (int rg = 0; rg < 4; ++rg) { const int t = t0 + fq * 4 + rg; h3[fr * 1024 + t] = acc[rg] * __expf(-((float)t * invL1) * dcq); }
            }
            __syncthreads();
            {
                const int order = wave >> 2, ci = wave & 3;
                const LAS float* hf = h3 + ((order * 2 + 0) * 4 + ci) * 1024; const LAS float* hb = h3 + ((order * 2 + 1) * 4 + ci) * 1024;
                float s = 0.f;
                for (int t = lane; t < L; t += 64) s += (t == 0) ? fabsf(hf[0] + hb[0]) : (fabsf(hf[t]) + fabsf(hb[t]));
                const float inv = 1.f / (wave_sum(s) + EPS);
                bf16_t* F = (bf16_t*)(P->ws + WS_FILT) + (size_t)l * FILT_L + (lv == 0 ? 0 : (size_t)2 * 1024 * 2048) + ((size_t)order * 1024 + c0 + ci) * (2 * L);
                for (int i = lane; i < 2 * L; i += 64) { const int lag = L - i;
                    float v; if (i == 0) v = 0.f; else if (lag > 0) v = hf[lag]; else if (lag == 0) v = hf[0] + hb[0]; else v = hb[-lag];
                    F[i] = f2bf(v * inv); }
            }
            __syncthreads();
        }
    }
}

__device__ __forceinline__ void scan_unit(PP P, int l, LAS unsigned char* lds, int path, int b, int h, int dir) {
    const int tid = TID(), lane = tid & 63, w = tid >> 6;
    const int L = path ? 1024 : 256, tb = path ? NCTX + b * 1024 : b * 256, nch = L >> 5;
    const bf16_t* proj = (const bf16_t*)(P->ws + WS_A);
    float* OP = (float*)(P->ws + WS_B + SZ_HYT) + (size_t)dir * NTOK * DA;
    const __amdgpu_buffer_rsrc_t ors = __builtin_amdgcn_make_buffer_rsrc((void*)OP, 0, (int)((size_t)NTOK * DA * 4), 0x00020000);
    constexpr int QB = 0, KB = 8704, KDT = 17408, VT0 = 27648, VTS = 10240, SB0 = 48128, SBS = 34816, ATT = 117760, GSUM = 120320, DEC = 122368;
    const int d = tid & 127, tg = tid >> 7;
    float lb = 0.f;
    if (l == 1) { const float x0 = P->in[I_LB][(0 * 2 + dir) * DA + h * 128 + d], x1 = P->in[I_LB][(1 * 2 + dir) * DA + h * 128 + d]; lb = __builtin_amdgcn_rcpf(1.f + __expf(x0 - x1)); }
    const float oml = 1.f - lb;
    const int et = w & 3, dtb = (w >> 2) * 4, fr = lane & 15, fq = lane >> 4;
    f32x4 st[2][4];
#pragma unroll
    for (int s2 = 0; s2 < 2; ++s2)
#pragma unroll
        for (int i = 0; i < 4; ++i) {
            st[s2][i] = (f32x4){0.f, 0.f, 0.f, 0.f};
            if (path) { const int dd = (dtb + i) * 16 + fq * 4, ee = s2 * 64 + et * 16 + fr;
                const float* sp = P->in[I_STATE] + ((((size_t)(b * 2 + l) * 2 + dir) * 8 + h) * 128 + dd) * 128 + ee;
                st[s2][i][0] = sp[0]; st[s2][i][1] = sp[128]; st[s2][i][2] = sp[256]; st[s2][i][3] = sp[384]; }
        }
    const int ve = tid & 127, vjg = tid >> 7;
    bf16_t qr[8], fz[8], vr[8], qr2[8], fz2[8], vr2[8];
    auto tokof = [&](int c, int j) { const int p = c * 32 + j; return tb + (dir ? (L - 1 - p) : p); };
    const __amdgpu_buffer_rsrc_t prs = __builtin_amdgcn_make_buffer_rsrc((void*)proj, 0, (int)((size_t)NTOK * NPROJ * 2), 0x00020000);
    const unsigned voff0 = (unsigned)(tb + (dir ? (L - 1 - (tg * 8 + 7)) : tg * 8)) * (unsigned)(NPROJ * 2) + (unsigned)((h * 128 + d) * 2);
    const int vstep = dir ? -(32 * NPROJ * 2) : (32 * NPROJ * 2);
    const int fcol = 2048 * (1 + dir);
    auto load_chunk = [&](int c, bf16_t (&q_)[8], bf16_t (&f_)[8], bf16_t (&v_)[8]) {
        const unsigned vo = voff0 + (unsigned)(c * vstep);
#pragma unroll
        for (int i = 0; i < 8; ++i) { const int ro = (dir ? (7 - i) : i) * (NPROJ * 2);
            q_[i] = __builtin_amdgcn_raw_buffer_load_b16(prs, vo, ro, 0); f_[i] = __builtin_amdgcn_raw_buffer_load_b16(prs, vo, ro + fcol, 0); v_[i] = __builtin_amdgcn_raw_buffer_load_b16(prs, vo, ro + 6144, 0); }
    };
    load_chunk(0, qr, fz, vr);
    load_chunk(1, qr2, fz2, vr2);
    float pre[8], kk[8];
    auto part1 = [&](int c) {
        const int SB = SB0 + (c & 1) * SBS, VT = VT0 + (c & 1) * VTS;
        float run = 0.f;
#pragma unroll
        for (int i = 0; i < 8; ++i) { const float z = bf2f(fz[i]); const float e = __expf(-fabsf(z)), r = __builtin_amdgcn_rcpf(1.f + e);
            const float sp = z >= 0.f ? r : e * r, sn = z >= 0.f ? e * r : r;
            run += __logf(lb + oml * sp); pre[i] = run; kk[i] = oml * sn; }
        ((LAS float*)(lds + GSUM))[tg * 128 + d] = run;
#pragma unroll
        for (int s2 = 0; s2 < 2; ++s2)
#pragma unroll
            for (int i = 0; i < 4; ++i) { u32x2 o; o.x = pk2(st[s2][i][0], st[s2][i][1]); o.y = pk2(st[s2][i][2], st[s2][i][3]);
                *(LAS u32x2*)(lds + SB + ((s2 * 64 + et * 16 + fr) * 136 + (dtb + i) * 16 + fq * 4) * 2) = o; }
        { u32x4 o; o.x = (unsigned)vr[0] | ((unsigned)vr[1] << 16); o.y = (unsigned)vr[2] | ((unsigned)vr[3] << 16); o.z = (unsigned)vr[4] | ((unsigned)vr[5] << 16); o.w = (unsigned)vr[6] | ((unsigned)vr[7] << 16);
          *(LAS u32x4*)(lds + VT + (ve * 40 + vjg * 8) * 2) = o; }
    };
    part1(0);
    LBAR();
#pragma unroll 1
    for (int c = 0; c < nch; ++c) {
        const int SB = SB0 + (c & 1) * SBS, VT = VT0 + (c & 1) * VTS;
        {
            const LAS float* gs = (const LAS float*)(lds + GSUM);
            const float g0 = gs[d], g1 = gs[128 + d], g2 = gs[256 + d], g3 = gs[384 + d];
            const float tot = g0 + g1 + g2 + g3;
            const float off = (tg == 0) ? 0.f : (tg == 1) ? g0 : (tg == 2) ? (g0 + g1) : (g0 + g1 + g2);
            const float etot = __expf(tot);
            float kd[8];
#pragma unroll
            for (int i = 0; i < 8; ++i) { const float bj = off + pre[i]; const int j = tg * 8 + i;
                const float q = bf2f(qr[i]); const float eb = __expf(bj), ebi = __expf(-bj);
                ((LAS bf16_t*)(lds + QB))[j * 136 + d] = f2bf(siluf_(q) * eb);
                const float kb = kk[i] * ebi;
                ((LAS bf16_t*)(lds + KB))[j * 136 + d] = f2bf(kb);
                kd[i] = kb * etot; }
            u32x4 o; o.x = pk2(kd[0], kd[1]); o.y = pk2(kd[2], kd[3]); o.z = pk2(kd[4], kd[5]); o.w = pk2(kd[6], kd[7]);
            *(LAS u32x4*)(lds + KDT + (d * 40 + tg * 8) * 2) = o;
            if (tg == 0) ((LAS float*)(lds + DEC))[d] = etot;
        }
        LBAR();
#pragma unroll
        for (int i = 0; i < 8; ++i) { qr[i] = qr2[i]; fz[i] = fz2[i]; vr[i] = vr2[i]; }
        if (c + 2 < nch) load_chunk(c + 2, qr2, fz2, vr2);
        const int tt = w >> 2;
        f32x4 acco[2];
#pragma unroll
        for (int s2 = 0; s2 < 2; ++s2) {
            acco[s2] = (f32x4){0.f, 0.f, 0.f, 0.f};
#pragma unroll
            for (int k4 = 0; k4 < 4; ++k4) {
                const bf16x8 a = *(const LAS bf16x8*)(lds + QB + ((tt * 16 + fr) * 136 + k4 * 32 + 8 * fq) * 2);
                const bf16x8 bb = *(const LAS bf16x8*)(lds + SB + ((s2 * 64 + et * 16 + fr) * 136 + k4 * 32 + 8 * fq) * 2);
                acco[s2] = __builtin_amdgcn_mfma_f32_16x16x32_bf16(a, bb, acco[s2], 0, 0, 0);
            }
        }
        if (w < 4) {
            const int tt2 = w >> 1, s2 = w & 1;
            f32x4 aa = (f32x4){0.f, 0.f, 0.f, 0.f};
            if (!(tt2 == 0 && s2 == 1)) {
#pragma unroll
                for (int k4 = 0; k4 < 4; ++k4) {
                    const bf16x8 a = *(const LAS bf16x8*)(lds + QB + ((tt2 * 16 + fr) * 136 + k4 * 32 + 8 * fq) * 2);
                    const bf16x8 bb = *(const LAS bf16x8*)(lds + KB + ((s2 * 16 + fr) * 136 + k4 * 32 + 8 * fq) * 2);
                    aa = __builtin_amdgcn_mfma_f32_16x16x32_bf16(a, bb, aa, 0, 0, 0);
                }
            }
#pragma unroll
            for (int rg = 0; rg < 4; ++rg) { const int t = tt2 * 16 + fq * 4 + rg, s = s2 * 16 + fr;
                ((LAS bf16_t*)(lds + ATT))[t * 40 + s] = f2bf(s <= t ? aa[rg] : 0.f); }
        }
#pragma unroll
        for (int s2 = 0; s2 < 2; ++s2) {
            const bf16x8 vb = *(const LAS bf16x8*)(lds + VT + ((s2 * 64 + et * 16 + fr) * 40 + 8 * fq) * 2);
#pragma unroll
            for (int i = 0; i < 4; ++i) {
                const f32x4 dv = *(const LAS f32x4*)(lds + DEC + ((dtb + i) * 16 + fq * 4) * 4);
                const bf16x8 ka = *(const LAS bf16x8*)(lds + KDT + (((dtb + i) * 16 + fr) * 40 + 8 * fq) * 2);
                const f32x4 s0 = st[s2][i] * dv;
                st[s2][i] = __builtin_amdgcn_mfma_f32_16x16x32_bf16(ka, vb, s0, 0, 0, 0);
            }
        }
        if (c + 1 < nch) part1(c + 1);
        LBAR();
        {
            const unsigned ovo = (unsigned)(tb + (dir ? (L - 1 - (c * 32 + tt * 16 + fq * 4 + 3)) : (c * 32 + tt * 16 + fq * 4))) * (unsigned)(DA * 4) + (unsigned)((h * 128 + et * 16 + fr) * 4);
            const bf16x8 a = *(const LAS bf16x8*)(lds + ATT + ((tt * 16 + fr) * 40 + 8 * fq) * 2);
#pragma unroll
            for (int s2 = 0; s2 < 2; ++s2) {
                const bf16x8 bb = *(const LAS bf16x8*)(lds + VT + ((s2 * 64 + et * 16 + fr) * 40 + 8 * fq) * 2);
                acco[s2] = __builtin_amdgcn_mfma_f32_16x16x32_bf16(a, bb, acco[s2], 0, 0, 0);
#pragma unroll
                for (int rg = 0; rg < 4; ++rg) __builtin_amdgcn_raw_buffer_store_b32(__float_as_uint(acco[s2][rg]), ors, ovo, (dir ? (3 - rg) : rg) * (DA * 4) + s2 * 256, 0);
            }
        }
    }
    LBAR();
    if (!path) {
        float* ns = P->out + (size_t)2 * NCTX * D;
#pragma unroll
        for (int s2 = 0; s2 < 2; ++s2)
#pragma unroll
            for (int i = 0; i < 4; ++i) { const int dd = (dtb + i) * 16 + fq * 4, ee = s2 * 64 + et * 16 + fr;
                float* sp = ns + ((((size_t)(b * 2 + l) * 2 + dir) * 8 + h) * 128 + dd) * 128 + ee;
                sp[0] = st[s2][i][0]; sp[128] = st[s2][i][1]; sp[256] = st[s2][i][2]; sp[384] = st[s2][i][3]; }
    }
}

struct HyRegs { u32x4 raw[3]; bf16_t prev[3], next[3]; u32x4 filt; };
__device__ __forceinline__ void hy_issue(PP P, int l, unsigned u, HyRegs& R) {
    const int tid = TID();
    const int lat = (int)(((u >> 8) + u) & 1u), c = (int)(u >> 1);
    const int L = lat ? 1024 : 256, TOK0 = lat ? NCTX : 0;
    const bf16_t* HYT = (const bf16_t*)(P->ws + WS_B);
    const int g8 = tid * 8, t = g8 & (L - 1);
#pragma unroll
    for (int sec = 0; sec < 3; ++sec) {
        const bf16_t* row = HYT + (size_t)(sec * 1024 + c) * NTOK + TOK0;
        R.raw[sec] = *(const u32x4*)(row + g8);
        R.prev[sec] = (t > 0) ? row[g8 - 1] : (bf16_t)0; R.next[sec] = (t + 8 < L) ? row[g8 + 8] : (bf16_t)0;
    }
    const bf16_t* F = (const bf16_t*)(P->ws + WS_FILT) + (size_t)l * FILT_L + (lat ? 0 : (size_t)2 * 1024 * 2048);
    const int NCH = 2 * L / 8;
    R.filt = (u32x4){0u, 0u, 0u, 0u};
    if (tid < 2 * NCH) { const int order = tid / NCH, j = tid - order * NCH; R.filt = *(const u32x4*)(F + ((size_t)order * 1024 + c) * (2 * L) + 8 * j); }
}
template <bool LAT>
__device__ __forceinline__ unsigned hyena_unit(PP P, int l, LAS unsigned char* lds, int c, HyRegs& R, unsigned* ctr, volatile LAS unsigned* qs) {
    constexpr int L = LAT ? 1024 : 256, NB = LAT ? 4 : 16, ZS = L + 136, RLEN = 2 * L + 136, TOK0 = LAT ? NCTX : 0;
    constexpr int SZ_Z = NB * ZS * 2, OFF_Z = 0, OFF_Z2 = SZ_Z, OFF_X1 = 2 * SZ_Z, OFF_X2 = OFF_X1 + 8192, OFF_R = OFF_X2 + 8192;
    const int tid = TID(), lane = tid & 63, w = tid >> 6, fr = lane & 15, fq = lane >> 4;
    bf16_t* OB = (bf16_t*)(P->ws + WS_OB);
    unsigned nreg = 0u;
    if (tid == 0) nreg = __hip_atomic_fetch_add(ctr, 1u, __ATOMIC_RELAXED, __HIP_MEMORY_SCOPE_AGENT);
    for (int i = tid; i < 2 * NB * 136; i += 512) { const int a = i / (NB * 136), r = (i / 136) % NB, p = i % 136; const int pos = p < 64 ? p : (L + p);
        ((LAS bf16_t*)(lds + (a ? OFF_Z2 : OFF_Z)))[r * ZS + pos] = 0; }
    {
        const int g8 = tid * 8, bb = g8 / L, t = g8 % L;
#pragma unroll
        for (int sec = 0; sec < 3; ++sec) {
            const int ch3 = sec * 1024 + c;
            const u32x4 raw = R.raw[sec];
            float x[10];
            x[0] = bf2f(R.prev[sec]); x[9] = bf2f(R.next[sec]);
            x[1] = bflo(raw.x); x[2] = bfhi(raw.x); x[3] = bflo(raw.y); x[4] = bfhi(raw.y); x[5] = bflo(raw.z); x[6] = bfhi(raw.z); x[7] = bflo(raw.w); x[8] = bfhi(raw.w);
            const float w0 = P->in[I_HYCW][(l * 3 + 0) * 3072 + ch3], w1 = P->in[I_HYCW][(l * 3 + 1) * 3072 + ch3], w2 = P->in[I_HYCW][(l * 3 + 2) * 3072 + ch3], bi = P->in[I_HYCB][l * 3072 + ch3];
            float y[8];
#pragma unroll
            for (int i = 0; i < 8; ++i) y[i] = w0 * x[i] + w1 * x[i + 1] + w2 * x[i + 2] + bi;
            u32x4 o; o.x = pk2(y[0], y[1]); o.y = pk2(y[2], y[3]); o.z = pk2(y[4], y[5]); o.w = pk2(y[6], y[7]);
            if (sec == 0) *(LAS u32x4*)(lds + OFF_Z + (bb * ZS + 64 + t) * 2) = o;
            else *(LAS u32x4*)(lds + (sec == 1 ? OFF_X1 : OFF_X2) + (bb * L + t) * 2) = o;
        }
    }
    {
        constexpr int NCH = 2 * L / 8;
        LAS bf16_t* Rl = (LAS bf16_t*)(lds + OFF_R);
        if (tid < 2 * NCH) { const int order = tid / NCH, j = tid - order * NCH;
            const u32x4 f = R.filt;
            *(LAS u32x4*)(lds + OFF_R + ((order * 2 + 0) * RLEN + 64 + 8 * j) * 2) = f;
            LAS bf16_t* r1 = Rl + (order * 2 + 1) * RLEN + 63 + 8 * j;
            r1[0] = (bf16_t)(f.x & 0xffffu); r1[1] = (bf16_t)(f.x >> 16); r1[2] = (bf16_t)(f.y & 0xffffu); r1[3] = (bf16_t)(f.y >> 16);
            r1[4] = (bf16_t)(f.z & 0xffffu); r1[5] = (bf16_t)(f.z >> 16); r1[6] = (bf16_t)(f.w & 0xffffu); r1[7] = (bf16_t)(f.w >> 16); }
        for (int i = tid; i < 4 * 136; i += 512) { const int oc = i / 136, q = i - oc * 136, cp = oc & 1; const int lo = 64 - cp;
            const int p = q < lo ? q : (2 * L + q); Rl[oc * RLEN + p] = 0; }
    }
    LBAR();
    unsigned un = 0xffffffffu;
#pragma unroll 1
    for (int order = 0; order < 2; ++order) {
        const int zin = order == 0 ? OFF_Z : OFF_Z2;
        const float bias = P->in[I_HYBIAS][(l * 2 + order) * 1024 + c];
        const int nb_ = LAT ? (fr & 3) : fr, m_ = LAT ? (fr >> 2) : 0;
        f32x4 acc2[2];
        acc2[0] = (f32x4){0.f, 0.f, 0.f, 0.f}; acc2[1] = (f32x4){0.f, 0.f, 0.f, 0.f};
        constexpr int TB = LAT ? 64 : 16, S0 = LAT ? -64 : 0, NIT = (L - S0) / 32;
        const int t0a = (w * 2) * TB;
        const int cp = fr & 1, p0 = L + 64 - (t0a - S0) - fr + 8 * fq;
        const LAS unsigned* rpa = (const LAS unsigned*)(lds + OFF_R + ((order * 2 + cp) * RLEN) * 2) + ((p0 - cp) >> 1);
        const LAS unsigned char* zp = lds + zin + (nb_ * ZS + 64 + S0 + 16 * m_ + 8 * fq) * 2;
        if constexpr (LAT) {
            u32x4 ap2, ap1;
            { const LAS unsigned* r2 = rpa - 32; const LAS unsigned* r1 = rpa - 16;
              ap2.x = r2[0]; ap2.y = r2[1]; ap2.z = r2[2]; ap2.w = r2[3]; ap1.x = r1[0]; ap1.y = r1[1]; ap1.z = r1[2]; ap1.w = r1[3]; }
#pragma unroll 2
            for (int it = 0; it < NIT; it += 2) {
                u32x4 a0, a1; const LAS unsigned* ra = rpa + it * 16;
                a0.x = ra[0]; a0.y = ra[1]; a0.z = ra[2]; a0.w = ra[3]; a1.x = ra[16]; a1.y = ra[17]; a1.z = ra[18]; a1.w = ra[19];
                const bf16x8 b0 = *(const LAS bf16x8*)(zp + it * 64), b1 = *(const LAS bf16x8*)(zp + it * 64 + 64);
                acc2[0] = __builtin_amdgcn_mfma_f32_16x16x32_bf16(__builtin_bit_cast(bf16x8, a0), b0, acc2[0], 0, 0, 0);
                acc2[1] = __builtin_amdgcn_mfma_f32_16x16x32_bf16(__builtin_bit_cast(bf16x8, ap2), b0, acc2[1], 0, 0, 0);
                acc2[0] = __builtin_amdgcn_mfma_f32_16x16x32_bf16(__builtin_bit_cast(bf16x8, a1), b1, acc2[0], 0, 0, 0);
                acc2[1] = __builtin_amdgcn_mfma_f32_16x16x32_bf16(__builtin_bit_cast(bf16x8, ap1), b1, acc2[1], 0, 0, 0);
                ap2 = a0; ap1 = a1;
            }
        } else {
#pragma unroll 2
            for (int it = 0; it < NIT; it += 2) {
                u32x4 av[2][2]; bf16x8 bv[2];
#pragma unroll
                for (int k = 0; k < 2; ++k) {
                    const LAS unsigned* ra = rpa + (it + k) * 16; const LAS unsigned* rb = ra - TB / 2;
                    av[k][0].x = ra[0]; av[k][0].y = ra[1]; av[k][0].z = ra[2]; av[k][0].w = ra[3];
                    av[k][1].x = rb[0]; av[k][1].y = rb[1]; av[k][1].z = rb[2]; av[k][1].w = rb[3];
                    bv[k] = *(const LAS bf16x8*)(zp + (it + k) * 64);
                }
#pragma unroll
                for (int k = 0; k < 2; ++k) {
                    acc2[0] = __builtin_amdgcn_mfma_f32_16x16x32_bf16(__builtin_bit_cast(bf16x8, av[k][0]), bv[k], acc2[0], 0, 0, 0);
                    acc2[1] = __builtin_amdgcn_mfma_f32_16x16x32_bf16(__builtin_bit_cast(bf16x8, av[k][1]), bv[k], acc2[1], 0, 0, 0);
                }
            }
        }
#pragma unroll
        for (int tb2 = 0; tb2 < 2; ++tb2) {
            const int t0 = t0a + tb2 * TB; const f32x4 acc = acc2[tb2];
            const int tq = t0 + 16 * m_ + fq * 4;
            const u32x2 zr = *(const LAS u32x2*)(lds + zin + (nb_ * ZS + 64 + tq) * 2);
            const u32x2 xr = *(const LAS u32x2*)(lds + (order == 0 ? OFF_X1 : OFF_X2) + (nb_ * L + tq) * 2);
            float r0 = bflo(xr.x) * (acc[0] + bias * bflo(zr.x)), r1 = bfhi(xr.x) * (acc[1] + bias * bfhi(zr.x));
            float r2 = bflo(xr.y) * (acc[2] + bias * bflo(zr.y)), r3 = bfhi(xr.y) * (acc[3] + bias * bfhi(zr.y));
            if (order == 0) { u32x2 o; o.x = pk2(r0, r1); o.y = pk2(r2, r3); *(LAS u32x2*)(lds + OFF_Z2 + (nb_ * ZS + 64 + tq) * 2) = o; }
            else { bf16_t* op = OB + (size_t)(TOK0 + nb_ * L + tq) * DA + c; op[0] = f2bf(r0); op[DA] = f2bf(r1); op[2 * DA] = f2bf(r2); op[3 * DA] = f2bf(r3); }
        }
        if (order == 0 && tid == 0) qs[0] = nreg;
        LBAR();
        if (order == 0) { un = qs[0]; if (un < 2048u) hy_issue(P, l, un, R); }
    }
    return un;
}

#ifndef DUP_SCAN
#define DUP_SCAN 0
#endif
#ifndef DUP_HY
#define DUP_HY 0
#endif
__device__ __forceinline__ void phase_mixers(PP P, int l, LAS unsigned char* lds) {
    for (int rep = 0; rep < 1 + DUP_SCAN; ++rep) {
    if (gridDim.x == 256) {
        const int bid = BID();
        if (bid < 64) scan_unit(P, l, lds, 1, bid >> 4, (bid >> 1) & 7, bid & 1);
        else { const int v = bid - 64; scan_unit(P, l, lds, 0, v >> 4, (v >> 1) & 7, v & 1);
               if (v < 64) { const int v2 = v + 192; scan_unit(P, l, lds, 0, v2 >> 4, (v2 >> 1) & 7, v2 & 1); } }
    } else {
        for (int slot = BID(); slot < 320; slot += gridDim.x) {
            if (slot < 64) scan_unit(P, l, lds, 1, slot >> 4, (slot >> 1) & 7, slot & 1);
            else { const int v = slot - 64; scan_unit(P, l, lds, 0, v >> 4, (v >> 1) & 7, v & 1); }
        }
    }
    __syncthreads();
    }
    unsigned* ctr = (unsigned*)(P->ws + WS_BAR) + 64 * l;
    volatile LAS unsigned* qs = (volatile LAS unsigned*)(lds + 131072 + 8);
    if (threadIdx.x == 0) qs[0] = __hip_atomic_fetch_add(ctr, 1u, __ATOMIC_RELAXED, __HIP_MEMORY_SCOPE_AGENT);
    __syncthreads();
    unsigned u = qs[0];
    __syncthreads();
    HyRegs R;
    if (u < 2048u) hy_issue(P, l, u, R);
    while (u < 2048u) {
        const int path = (int)(((u >> 8) + u) & 1u), c = (int)(u >> 1);
        u = path ? hyena_unit<true>(P, l, lds, c, R, ctr, qs) : hyena_unit<false>(P, l, lds, c, R, ctr, qs);
    }
}

__device__ __forceinline__ void phase_combine(PP P, int l) {
    const int tid_ = TID(), lane = tid_ & 63, gw = BID() * 8 + (tid_ >> 6), NGW = gridDim.x * 8;
    const float* OP = (const float*)(P->ws + WS_B + SZ_HYT);
    const bf16_t* proj = (const bf16_t*)(P->ws + WS_A);
    bf16_t* OA = (bf16_t*)(P->ws + WS_OA);
    const int li = lane & 31, half = lane >> 5;
    const f32x4 wn = *(const f32x4*)(P->in[I_HNORM] + l * 128 + 4 * li);
    for (int it = gw; it < NTOK * 4; it += NGW) {
        const int item = it * 2 + half, tok = item >> 3, h = item & 7;
        const size_t off = (size_t)tok * DA + h * 128 + 4 * li;
        f32x4 o = *(const f32x4*)(OP + off); const f32x4 o2 = *(const f32x4*)(OP + (size_t)NTOK * DA + off);
        o[0] += o2[0]; o[1] += o2[1]; o[2] += o2[2]; o[3] += o2[3];
        float ss = o[0] * o[0] + o[1] * o[1] + o[2] * o[2] + o[3] * o[3];
#pragma unroll
        for (int s = 1; s < 32; s <<= 1) ss += __shfl_xor(ss, s);
        const float r = rsqrtf(ss * (1.f / 128.f) + EPS);
        const u32x2 g = *(const u32x2*)(proj + (size_t)tok * NPROJ + 4096 + h * 128 + 4 * li);
        u32x2 out; out.x = pk2(o[0] * r * wn[0] * siluf_(bflo(g.x)), o[1] * r * wn[1] * siluf_(bfhi(g.x)));
        out.y = pk2(o[2] * r * wn[2] * siluf_(bflo(g.y)), o[3] * r * wn[3] * siluf_(bfhi(g.y)));
        *(u32x2*)(OA + off) = out;
    }
}

typedef float f32x2 __attribute__((ext_vector_type(2)));
template <bool LAT>
__device__ __forceinline__ void ffn_sweep2(const bf16_t* __restrict__ U, bf16_t* __restrict__ ACT, const float* __restrict__ cw, const float* __restrict__ cb,
                                           int tok0, int xstart, bool rup, bool rdn, int c2) {
    constexpr int NI = LAT ? 4 : 2, NK = LAT ? 3 : 1, W = LAT ? 64 : 256, GS = 4, NG = 32 / GS;
    f32x2 wa[NK][3], wv[NK][3];
#pragma unroll
    for (int ry = 0; ry < NK; ++ry)
#pragma unroll
        for (int kx = 0; kx < 3; ++kx) { const int ky = LAT ? ry : 1; const float* wp = cw + (size_t)(ky * 3 + kx) * NUP + c2;
            wa[ry][kx] = *(const f32x2*)wp; wv[ry][kx] = *(const f32x2*)(wp + DFF); }
    const f32x2 ba = *(const f32x2*)(cb + c2), bv = *(const f32x2*)(cb + DFF + c2);
    unsigned ca[GS + 2][NI], cv[GS + 2][NI], na[GS][NI], nv[GS][NI];
    auto ld = [&](int x, unsigned (&a)[NI], unsigned (&v)[NI]) {
#pragma unroll
        for (int i = 0; i < NI; ++i) {
            const int xi = LAT ? x : x + 32 * i;
            const bool ok = (xi >= 0) && (xi < W) && (!LAT || (i == 0 ? rup : (i == 3 ? rdn : true)));
            a[i] = 0u; v[i] = 0u;
            if (ok) { const size_t off = (size_t)(tok0 + (x - xstart) + (LAT ? (i - 1) * 64 : 32 * i)) * NUP + c2; a[i] = *(const unsigned*)(U + off); v[i] = *(const unsigned*)(U + off + DFF); }
        }
    };
#pragma unroll
    for (int k = 0; k < GS + 2; ++k) ld(xstart - 1 + k, ca[k], cv[k]);
#pragma unroll 1
    for (int g = 0; g < NG; ++g) {
        const int x = xstart + GS * g;
        if (g < NG - 1) {
#pragma unroll
            for (int k = 0; k < GS; ++k) ld(x + GS + 1 + k, na[k], nv[k]);
        }
#pragma unroll
        for (int st = 0; st < GS; ++st) {
#pragma unroll
            for (int o = 0; o < 2; ++o) {
                f32x2 sa = ba, sv = bv;
#pragma unroll
                for (int ry = 0; ry < NK; ++ry)
#pragma unroll
                    for (int kx = 0; kx < 3; ++kx) { const unsigned a = ca[st + kx][LAT ? (o + ry) : o], v = cv[st + kx][LAT ? (o + ry) : o];
                        sa += wa[ry][kx] * (f32x2){bflo(a), bfhi(a)}; sv += wv[ry][kx] * (f32x2){bflo(v), bfhi(v)}; }
                *(unsigned*)(ACT + (size_t)(tok0 + GS * g + st + (LAT ? 64 * o : 32 * o)) * DFF + c2) = pk2(siluf_(sa[0]) * sv[0], siluf_(sa[1]) * sv[1]);
            }
        }
#pragma unroll
        for (int i = 0; i < NI; ++i) { ca[0][i] = ca[GS][i]; ca[1][i] = ca[GS + 1][i]; cv[0][i] = cv[GS][i]; cv[1][i] = cv[GS + 1][i];
#pragma unroll
            for (int k = 0; k < GS; ++k) { ca[2 + k][i] = na[k][i]; cv[2 + k][i] = nv[k][i]; } }
    }
}
__device__ __forceinline__ void phase_ffnconv(PP P, int l) {
    const int tid = TID();
    const bf16_t* U = (const bf16_t*)(P->ws + WS_A);
    bf16_t* ACT = (bf16_t*)(P->ws + WS_B);
    const float* cw = P->in[I_FCW] + (size_t)l * 9 * NUP; const float* cb = P->in[I_FCB] + (size_t)l * NUP;
    for (int blk = BID(); blk < 256; blk += gridDim.x) {
        const int v = (gridDim.x == 256) ? ((blk & 7) * 32 + (blk >> 3)) : blk;
        const int lu = v >> 2, qt = v & 3;
        for (int idx = tid; idx < 1408; idx += 512) {
            if (idx < 704) { const int bb = lu >> 4, rp = (lu >> 1) & 7, xh = lu & 1, r = 2 * rp;
                ffn_sweep2<true>(U, ACT, cw, cb, NCTX + bb * 1024 + r * 64 + xh * 32, xh * 32, r > 0, r + 2 < 16, 2 * (qt * 704 + idx)); }
            else { const int bb = lu >> 2, sp = lu & 3;
                ffn_sweep2<false>(U, ACT, cw, cb, bb * 256 + sp * 64, sp * 64, true, true, 2 * (qt * 704 + idx - 704)); }
        }
    }
}

#define XB_TMO      128
#define XB_XCNT(j)  (256  + 64 * (j))
#define XB_XSUB(j)  (1280 + 64 * (j))
#define XB_XGEN(j)  (2304 + 64 * (j))
#define XB_TOP      3328
#define XB_TOPGEN   3392
#define XCD_BAR_WORDS 3456
#define XB_SPIN_CAP (1u << 18)
__device__ __forceinline__ unsigned xb_ld(unsigned* p)              { return __hip_atomic_load(p, __ATOMIC_RELAXED, __HIP_MEMORY_SCOPE_AGENT); }
__device__ __forceinline__ unsigned xb_add(unsigned* p, unsigned v) { return __hip_atomic_fetch_add(p, v, __ATOMIC_RELAXED, __HIP_MEMORY_SCOPE_AGENT); }
__device__ __forceinline__ unsigned xb_xcc_id() { return (unsigned)__builtin_amdgcn_s_getreg((3 << 11) | 20) & 0xFu; }
#define XB_SPIN(cond, bar) do { unsigned _sp = 0; while (cond) { __builtin_amdgcn_s_sleep(1); \
    if ((++_sp & 255u) == 0u) { if (xb_ld(&(bar)[XB_TMO])) break; if (_sp > XB_SPIN_CAP) { atomicAdd(&(bar)[XB_TMO], 1u); break; } } } } while (0)
struct XcdBarrier { unsigned* bar; unsigned x; volatile LAS unsigned* st; };
__device__ __forceinline__ XcdBarrier xcd_barrier_post(unsigned* bar, volatile LAS unsigned* st) {
    XcdBarrier b; b.bar = bar; b.x = xb_xcc_id(); b.st = st;
    if (threadIdx.x == 0) (void)xb_add(&bar[XB_XCNT(b.x)], 1u);
    return b;
}
__device__ __forceinline__ void xcd_barrier_complete(unsigned* bar, unsigned x, unsigned& nloc, unsigned& nx) {
    const unsigned G = gridDim.x * gridDim.y * gridDim.z;
    unsigned sum, cnt, mine, sp = 0u;
    for (;;) {
        sum = 0u; cnt = 0u; mine = 0u;
#pragma unroll
        for (unsigned j = 0; j < 16; ++j) { const unsigned c = xb_ld(&bar[XB_XCNT(j)]); sum += c; cnt += (c > 0u) ? 1u : 0u; mine = (j == x) ? c : mine; }
        if (sum == G) break;
        __builtin_amdgcn_s_sleep(1);
        if ((++sp & 255u) == 0u) { if (xb_ld(&bar[XB_TMO])) break; if (sp > XB_SPIN_CAP) { atomicAdd(&bar[XB_TMO], 1u); break; } }
    }
    nloc = mine > 0u ? mine : 1u; nx = cnt > 0u ? cnt : 1u;
}
__device__ __forceinline__ void xcd_barrier(const XcdBarrier& b) {
    asm volatile("s_waitcnt vmcnt(0)" ::: "memory");
    __syncthreads();
    if (threadIdx.x == 0) {
        unsigned* bar = b.bar;
        __builtin_amdgcn_s_waitcnt(0);
        unsigned nloc = b.st[0], nx = b.st[1];
        if (nloc == 0u) { xcd_barrier_complete(bar, b.x, nloc, nx); b.st[0] = nloc; b.st[1] = nx; }
        const unsigned old = xb_add(&bar[XB_XSUB(b.x)], 1u);
        const unsigned gen = old / nloc;
        if (old + 1u == (gen + 1u) * nloc) {
            __builtin_amdgcn_fence(__ATOMIC_RELEASE, "agent");
            asm volatile("s_waitcnt vmcnt(0)" ::: "memory");
            const unsigned og = xb_add(&bar[XB_TOP], 1u);
            const unsigned tg = og / nx;
            if (og + 1u == (tg + 1u) * nx) xb_add(&bar[XB_TOPGEN], 1u);
            else XB_SPIN(xb_ld(&bar[XB_TOPGEN]) == tg, bar);
            __builtin_amdgcn_fence(__ATOMIC_ACQUIRE, "agent");
            xb_add(&bar[XB_XGEN(b.x)], 1u);
            asm volatile("s_waitcnt vmcnt(0)" ::: "memory");
        } else {
            XB_SPIN(xb_ld(&bar[XB_XGEN(b.x)]) == gen, bar);
            __builtin_amdgcn_fence(__ATOMIC_ACQUIRE, "agent");
            asm volatile("s_waitcnt vmcnt(0)" ::: "memory");
        }
    }
    __syncthreads();
}

__device__ __forceinline__ void run_phase(PP P, int ph, LAS unsigned char* lds) {
    using namespace pg8;
#ifndef PMASK
#define PMASK 0xFFF
#endif
    if (ph == 0) { if (PMASK & 1) phase_prologue(P, lds); return; }
    if (ph == 1) { if (PMASK & 2) { prenorm_rows(P); filter_units(P, lds); } return; }
    const int l = (ph - 2) / 10, sp = (ph - 2) % 10;
    StaticOrder S;
    if (!((PMASK >> (2 + sp)) & 1)) return;
    switch (sp) {
    case 0: {
        Gemm g{(const bf16_t*)(P->ws + WS_HB), (const bf16_t*)(P->ws + WS_WIN + l * SZ_WIN), NTOK, NPROJ, D};
        S.init(NTOK, NPROJ, gridDim.x, BID(), 20, 32);
        Epi<EP_PROJ> E{(bf16_t*)(P->ws + WS_A), NPROJ, nullptr, nullptr, nullptr, (bf16_t*)(P->ws + WS_B)};
        gemm_phase(lds, g, S, E); break; }
    case 1: phase_mixers(P, l, lds); break;
    case 2: phase_combine(P, l); break;
    case 3: {
        Gemm ga{(const bf16_t*)(P->ws + WS_OA), (const bf16_t*)(P->ws + WS_WA + l * SZ_WBR), NTOK, D, DA};
        S.init(NTOK, D, gridDim.x, BID(), 0, 0);
        Epi<EP_BRA> Ea{(bf16_t*)(P->ws + WS_D), D, nullptr, (const bf16_t*)(P->ws + WS_A) + 8192, nullptr, nullptr};
        gemm_phase(lds, ga, S, Ea);
        Gemm gb{(const bf16_t*)(P->ws + WS_OB), (const bf16_t*)(P->ws + WS_WB + l * SZ_WBR), NTOK, D, DA};
        Epi<EP_BRB> Eb{(bf16_t*)(P->ws + WS_D + (size_t)NTOK * D * 2), D, nullptr, (const bf16_t*)(P->ws + WS_A) + 10240, (const bf16_t*)(P->ws + WS_D), nullptr};
        gemm_phase(lds, gb, S, Eb); break; }
    case 4: {
        Gemm g{(const bf16_t*)(P->ws + WS_D + (size_t)NTOK * D * 2), (const bf16_t*)(P->ws + WS_WOUT + l * SZ_WOUT), NTOK, D, D};
        S.init(NTOK, D, gridDim.x, BID(), 0, 0);
        Epi<EP_BF16> E{(bf16_t*)(P->ws + WS_B), D, nullptr, nullptr, nullptr, nullptr};
        gemm_phase(lds, g, S, E); break; }
    case 5: row_phase(P, l, (const bf16_t*)(P->ws + WS_B), 0); break;
    case 6: {
        Gemm g{(const bf16_t*)(P->ws + WS_HB), (const bf16_t*)(P->ws + WS_WUP + l * SZ_WUP), NTOK, NUP, D};
        S.init(NTOK, NUP, gridDim.x, BID(), 0, 0);
        Epi<EP_BF16> E{(bf16_t*)(P->ws + WS_A), NUP, nullptr, nullptr, nullptr, nullptr};
        gemm_phase(lds, g, S, E); break; }
    case 7: phase_ffnconv(P, l); break;
    case 8: {
        Gemm g{(const bf16_t*)(P->ws + WS_B), (const bf16_t*)(P->ws + WS_WDN + l * SZ_WDN), NTOK, D, DFF};
        S.init(NTOK, D, gridDim.x, BID(), 0, 0);
        Epi<EP_BF16> E{(bf16_t*)(P->ws + WS_D), D, nullptr, nullptr, nullptr, nullptr};
        gemm_phase(lds, g, S, E); break; }
    case 9: row_phase(P, l, (const bf16_t*)(P->ws + WS_D), 1); break;
    }
}

__global__ void __launch_bounds__(512, 2) fwd_kernel(Params Pv) {
    extern __shared__ __attribute__((aligned(16))) unsigned char shm[];
    PP P = (PP)__builtin_amdgcn_kernarg_segment_ptr();
    LAS unsigned char* lds = (LAS unsigned char*)shm;
    cg::grid_group grid = cg::this_grid();
    if (threadIdx.x < 4) ((LAS unsigned*)(lds + 131072))[threadIdx.x] = 0u;
    __syncthreads();
    (void)xcd_barrier_post((unsigned*)(P->ws + WS_BAR), (volatile LAS unsigned*)(lds + 131072));
#pragma unroll
    for (int ph = 0; ph < NPHASE; ++ph) {
        if (ph >= P->ph_lo && ph < P->ph_hi) {
            if (ph > P->ph_lo) { if (P->ph_hi > NPHASE) grid.sync(); else { XcdBarrier xb; xb.bar = (unsigned*)(P->ws + WS_BAR); xb.x = xb_xcc_id(); xb.st = (volatile LAS unsigned*)(lds + 131072); xcd_barrier(xb); } }
            run_phase(P, ph, lds);
#if DUPMASK
            if ((DUPMASK >> ph) & 1) { __syncthreads(); run_phase(P, ph, lds); }
#endif
        }
    }
}

extern "C" void kernel_launch(void* const* d_in, const int* in_sizes, int n_in, void* d_out, int out_size, void* d_ws, size_t ws_size, hipStream_t stream) {
    static int grid = 0;
    if (grid == 0) {
        if (n_in != 30 || ws_size < WS_END) { fprintf(stderr, "kernel_launch: expected 30 inputs and >= %zu bytes of workspace; got %d, %zu\n", (size_t)WS_END, n_in, ws_size); grid = -1; return; }
        int dev = 0, cus = 0, per_cu = 0;
        hipGetDevice(&dev); hipDeviceGetAttribute(&cus, hipDeviceAttributeMultiprocessorCount, dev);
        if (hipFuncSetAttribute((const void*)fwd_kernel, hipFuncAttributeMaxDynamicSharedMemorySize, LDS_BYTES) != hipSuccess) { fprintf(stderr, "kernel_launch: hipFuncSetAttribute failed\n"); grid = -1; return; }
        hipOccupancyMaxActiveBlocksPerMultiprocessor(&per_cu, (const void*)fwd_kernel, 512, LDS_BYTES);
        if (per_cu < 1) { fprintf(stderr, "kernel_launch: occupancy query reports %d blocks per CU\n", per_cu); per_cu = 1; }
        (void)hipGetLastError();
        grid = cus;
    }
    if (grid < 0) return;
    Params p{};
    for (int i = 0; i < 30; ++i) p.in[i] = (const float*)d_in[i];
    p.out = (float*)d_out; p.ws = (unsigned char*)d_ws;
    if (hipMemsetAsync((char*)d_ws + WS_BAR, 0, 16384, stream) != hipSuccess) { fprintf(stderr, "kernel_launch: memset of the barrier words failed\n"); return; }
#if PER_PHASE_LAUNCH
    for (int ph = 0; ph < NPHASE; ++ph) {
        p.ph_lo = ph; p.ph_hi = ph + 1;
        hipLaunchKernelGGL(fwd_kernel, dim3(grid), dim3(512), LDS_BYTES, stream, p);
    }
#else
    p.ph_lo = 0; p.ph_hi = NPHASE;
    void* args[] = {&p};
    hipError_t e = hipLaunchCooperativeKernel((const void*)fwd_kernel, dim3(grid), dim3(512), args, LDS_BYTES, stream);
    if (e != hipSuccess) fprintf(stderr, "cooperative launch failed: %s (grid %d)\n", hipGetErrorString(e), grid);
#endif
}
```

```cpp
#include <hip/hip_runtime.h>
#include <hip/hip_cooperative_groups.h>
#include <cstdio>
#include <cstdint>
namespace cg = cooperative_groups;

#ifndef PER_PHASE_LAUNCH
#define PER_PHASE_LAUNCH 0
#endif

#ifndef DUPMASK
#define DUPMASK 0
#endif
#define LAS __attribute__((address_space(3)))
typedef unsigned short bf16_t;
typedef short bf16x8 __attribute__((ext_vector_type(8)));
typedef float f32x4 __attribute__((ext_vector_type(4)));
typedef unsigned u32x4 __attribute__((ext_vector_type(4)));
typedef unsigned u32x2 __attribute__((ext_vector_type(2)));

constexpr int D = 2048, NTOK = 8192, NCTX = 4096, NPROJ = 12288, DA = 1024, DFF = 5632, NUP = 11264, NMOD = 12288;
constexpr float EPS = 1e-6f;
constexpr int LDS_BYTES = 131072 + 16;
constexpr int NPHASE = 22;

constexpr size_t SZ_WIN = (size_t)NPROJ * D * 2, SZ_WBR = (size_t)D * DA * 2, SZ_WOUT = (size_t)D * D * 2, SZ_WUP = (size_t)NUP * D * 2, SZ_WDN = (size_t)D * DFF * 2;
constexpr size_t WS_WIN = 0;
constexpr size_t WS_WA = WS_WIN + 2 * SZ_WIN;
constexpr size_t WS_WB = WS_WA + 2 * SZ_WBR;
constexpr size_t WS_WOUT = WS_WB + 2 * SZ_WBR;
constexpr size_t WS_WUP = WS_WOUT + 2 * SZ_WOUT;
constexpr size_t WS_WDN = WS_WUP + 2 * SZ_WUP;
constexpr size_t WS_MOD = WS_WDN + 2 * SZ_WDN;
constexpr size_t WS_H2 = WS_MOD + (size_t)2 * 5 * NMOD * 4;
constexpr size_t FILT_L = (size_t)2 * 1024 * 2048 + (size_t)2 * 1024 * 512;
constexpr size_t WS_FILT = WS_H2 + (size_t)2 * 1280 * 64 * 4;
constexpr size_t WS_HB = WS_FILT + 2 * FILT_L * 2;
constexpr size_t WS_OA = WS_HB + (size_t)NTOK * D * 2;
constexpr size_t WS_OB = WS_OA + (size_t)NTOK * DA * 2;
constexpr size_t WS_A = WS_OB + (size_t)NTOK * DA * 2;
constexpr size_t WS_B = WS_A + (size_t)NTOK * NPROJ * 2;
constexpr size_t SZ_HYT = (size_t)3072 * NTOK * 2;
constexpr size_t WS_D = WS_B + SZ_HYT + (size_t)2 * NTOK * DA * 4;
constexpr size_t WS_BAR = WS_D + (size_t)NTOK * D * 4;
constexpr size_t WS_END = WS_BAR + 16384;

struct Params {
    const float* in[30];
    float* out; unsigned char* ws;
    int ph_lo, ph_hi;
};
typedef const __attribute__((address_space(4))) Params* PP;
enum { I_XP = 0, I_XS, I_STATE, I_C, I_CCTX, I_WMOD, I_BMOD, I_GPREMIX, I_GPOSTMIX, I_GPREFFN, I_GPOSTFFN, I_WIN, I_LB, I_HNORM, I_HYCW, I_HYCB,
       I_HYW1, I_HYB1, I_HYW2, I_HYB2, I_HYW3, I_HYDEC, I_HYBIAS, I_WA, I_WB, I_WOUT, I_WUP, I_FCW, I_FCB, I_WDN };

__device__ __forceinline__ float bf2f(unsigned b) { return __uint_as_float(b << 16); }
__device__ __forceinline__ float bflo(unsigned w) { return __uint_as_float(w << 16); }
__device__ __forceinline__ float bfhi(unsigned w) { return __uint_as_float(w & 0xffff0000u); }
__device__ __forceinline__ unsigned pk2(float lo, float hi) { unsigned r; asm("v_cvt_pk_bf16_f32 %0, %1, %2" : "=v"(r) : "v"(lo), "v"(hi)); return r; }
__device__ __forceinline__ bf16_t f2bf(float f) { return (bf16_t)(pk2(f, 0.f) & 0xffffu); }
__device__ __forceinline__ float wave_sum(float v) {
#pragma unroll
    for (int o = 1; o < 64; o <<= 1) v += __shfl_xor(v, o);
    return v;
}
#define LBAR() do { asm volatile("s_waitcnt lgkmcnt(0)" ::: "memory"); __builtin_amdgcn_s_barrier(); asm volatile("" ::: "memory"); } while (0)
__device__ __forceinline__ int TID() { int t = threadIdx.x; asm volatile("" : "+v"(t)); return t; }
__device__ __forceinline__ int BID() { int b = blockIdx.x; asm volatile("" : "+s"(b)); return b; }
__device__ __forceinline__ float sigmoidf_(float z) { return __builtin_amdgcn_rcpf(1.f + __expf(-z)); }
__device__ __forceinline__ float siluf_(float z) { return z * __builtin_amdgcn_rcpf(1.f + __expf(-z)); }

namespace pg8 {
constexpr int BM = 256, BK = 64, HALF = 128, HTB = HALF * BK * 2, STAGE_BYTES = 8 * HTB, NXCD = 8, WGM = 8;
__host__ __device__ __forceinline__ int lds_byte(int r, int c) { const int st = (r >> 4) * 2 + (c >> 5), rr = r & 15, cc = c & 31, ob = rr * 64 + cc * 2; return st * 1024 + (ob ^ (((ob >> 9) & 1) << 5)); }
__host__ __device__ __forceinline__ void stage_rc(int b, int& R, int& C) { const int st = b / 1024, sb = b % 1024, swz = sb ^ (((sb >> 9) & 1) << 5); R = (st >> 1) * 16 + swz / 64; C = (st & 1) * 32 + (swz % 64) / 2; }
__host__ __device__ __forceinline__ int perm32(int rho) { const int n = rho >> 4, i = rho & 15; return 8 * (i >> 2) + 4 * n + (i & 3); }

struct Unit { int pm, pn; };
struct Gemm { const bf16_t* A; const bf16_t* Bt; int M, N, K; };

struct StaticOrder {
    int nM, nN, nwg, G, c, sw_lo, sw_hi;
    __device__ void init(int M, int N, int G_, int c_, int swlo, int swhi) { nM = M / BM; nN = N / BM; nwg = nM * nN; G = G_; c = c_; sw_lo = swlo; sw_hi = swhi; }
    __device__ bool next(int i, Unit& u) const {
        const long L = (long)i * G + c; if (L >= nwg) return false;
        int wgid = (int)L; { const int q = nwg / NXCD, r = nwg % NXCD, xcd = wgid % NXCD, off = wgid / NXCD; wgid = (xcd < r ? xcd * (q + 1) : r * (q + 1) + (xcd - r) * q) + off; }
        const int nig = WGM * nN, gid = wgid / nig, fm = gid * WGM, gsz = (nM - fm) < WGM ? (nM - fm) : WGM;
        u.pm = fm + ((wgid % nig) % gsz); u.pn = (wgid % nig) / gsz; return true;
    }
    __device__ __forceinline__ bool is_sw(const Unit& u) const { return u.pn >= sw_lo && u.pn < sw_hi; }
};

enum { EP_PROJ = 0, EP_BF16 = 1, EP_BRA = 2, EP_BRB = 3, EP_F32 = 4 };
template <int MODE> struct Epi {
    static constexpr bool PERM = (MODE != EP_F32);
    bf16_t* O; int ldc; float* C; const bf16_t* G; const bf16_t* T; bf16_t* HYT;
    __device__ __forceinline__ void operator()(const f32x4 (&acc)[2][2][4][2], const Unit& u, bool sw, int wr, int wc, int fr, int fq) const {
        if constexpr (MODE == EP_F32) {
            const int row0 = u.pm * BM + wr * 64 + fr, col0 = u.pn * BM + wc * 32 + 4 * fq;
#pragma unroll
            for (int ai = 0; ai < 2; ++ai)
#pragma unroll
                for (int m = 0; m < 4; ++m) { float* rowp = C + (size_t)(row0 + ai * HALF + m * 16) * ldc + col0;
#pragma unroll
                    for (int bj = 0; bj < 2; ++bj)
#pragma unroll
                        for (int n = 0; n < 2; ++n) *(f32x4*)(rowp + bj * HALF + n * 16) = acc[ai][bj][m][n]; }
        } else {
            if (MODE == EP_PROJ && sw) {
                const int ch0 = (u.pn - 20) * BM + wr * 64 + fr, tok0 = u.pm * BM + wc * 32 + 8 * fq;
#pragma unroll
                for (int ai = 0; ai < 2; ++ai)
#pragma unroll
                    for (int m = 0; m < 4; ++m) { bf16_t* rowp = HYT + (size_t)(ch0 + ai * HALF + m * 16) * NTOK + tok0;
#pragma unroll
                        for (int bj = 0; bj < 2; ++bj) { const f32x4 v0 = acc[ai][bj][m][0], v1 = acc[ai][bj][m][1];
                            u32x4 o; o.x = pk2(v0[0], v0[1]); o.y = pk2(v0[2], v0[3]); o.z = pk2(v1[0], v1[1]); o.w = pk2(v1[2], v1[3]);
                            *(u32x4*)(rowp + bj * HALF) = o; } }
                return;
            }
            const int row0 = u.pm * BM + wr * 64 + fr, col0 = u.pn * BM + wc * 32 + 8 * fq;
#pragma unroll
            for (int ai = 0; ai < 2; ++ai)
#pragma unroll
                for (int m = 0; m < 4; ++m) { const size_t r = (size_t)(row0 + ai * HALF + m * 16);
#pragma unroll
                    for (int bj = 0; bj < 2; ++bj) { f32x4 v0 = acc[ai][bj][m][0], v1 = acc[ai][bj][m][1]; const int cc = col0 + bj * HALF;
                        if constexpr (MODE == EP_BRA || MODE == EP_BRB) {
                            const u32x4 g = *(const u32x4*)(G + r * NPROJ + cc);
                            v0[0] *= sigmoidf_(bflo(g.x)); v0[1] *= sigmoidf_(bfhi(g.x)); v0[2] *= sigmoidf_(bflo(g.y)); v0[3] *= sigmoidf_(bfhi(g.y));
                            v1[0] *= sigmoidf_(bflo(g.z)); v1[1] *= sigmoidf_(bfhi(g.z)); v1[2] *= sigmoidf_(bflo(g.w)); v1[3] *= sigmoidf_(bfhi(g.w));
                        }
                        if constexpr (MODE == EP_BRB) {
                            const u32x4 t = *(const u32x4*)(T + r * ldc + cc);
                            v0[0] += bflo(t.x); v0[1] += bfhi(t.x); v0[2] += bflo(t.y); v0[3] += bfhi(t.y);
                            v1[0] += bflo(t.z); v1[1] += bfhi(t.z); v1[2] += bflo(t.w); v1[3] += bfhi(t.w);
                        }
                        u32x4 o; o.x = pk2(v0[0], v0[1]); o.y = pk2(v0[2], v0[3]); o.z = pk2(v1[0], v1[1]); o.w = pk2(v1[2], v1[3]);
                        *(u32x4*)(O + r * ldc + cc) = o; } }
        }
    }
};

#ifndef GEMM_SP2
#define GEMM_SP2 1
#endif
#ifndef GEMM_ALIGN
#define GEMM_ALIGN 1
#endif
template <class EpiT, bool ALIGN_EPI = (GEMM_ALIGN != 0), bool SP2 = (GEMM_SP2 != 0)>
__device__ __forceinline__ void gemm_phase(LAS unsigned char* lds, const Gemm g, const StaticOrder& S, const EpiT& E) {
    const int tid = TID(), wid = __builtin_amdgcn_readfirstlane(tid >> 6), lane = tid & 63, wr = wid >> 2, wc = wid & 3, fr = lane & 15, fq = lane >> 4;
    const int K = g.K, nt = K / BK;
    unsigned voffA[2], voffB[2];
#pragma unroll
    for (int i = 0; i < 2; ++i) { int R, C; stage_rc(tid * 16 + i * 8192, R, C); const int Rb = EpiT::PERM ? ((R & ~31) + perm32(R & 31)) : R;
        voffA[i] = (unsigned)(R * K + C) * 2u; voffB[i] = (unsigned)(Rb * K + C) * 2u; }
    const size_t kstep = (size_t)(BK * 2);
    const size_t hstep = (size_t)HALF * K * 2;
    const size_t tstep = 2 * hstep;
    const unsigned ldsw = (unsigned)wid * 1024u;
    const int aoff = lds_byte(wr * 64 + fr, fq * 8), boff = lds_byte(wc * 32 + fr, fq * 8);
#define PG8_SA(b, h) (((b) * 2 + (h)) * HTB)
#define PG8_SB(b, h) ((4 + (b) * 2 + (h)) * HTB)
#define PG8_STAGE(bufoff, gbase, voff) do { _Pragma("unroll") for (int _i = 0; _i < 2; ++_i) \
        __builtin_amdgcn_global_load_lds((const unsigned*)((const char*)(gbase) + (voff)[_i]), (LAS unsigned*)(lds + (bufoff) + ldsw + _i * 8192), 16, 0, 0); } while (0)
#define PG8_LDA(dst, b, h) do { _Pragma("unroll") for (int m = 0; m < 4; ++m) _Pragma("unroll") for (int k = 0; k < 2; ++k) dst[m][k] = *(const LAS bf16x8*)(lds + PG8_SA(b, h) + aoff + m * 2048 + k * 1024); } while (0)
#define PG8_LDB(dst, b, h) do { _Pragma("unroll") for (int n = 0; n < 2; ++n) _Pragma("unroll") for (int k = 0; k < 2; ++k) dst[n][k] = *(const LAS bf16x8*)(lds + PG8_SB(b, h) + boff + n * 2048 + k * 1024); } while (0)
#define PG8_MMA(ai, bj, At, Bt) do { __builtin_amdgcn_s_setprio(1); _Pragma("unroll") for (int m = 0; m < 4; ++m) _Pragma("unroll") for (int n = 0; n < 2; ++n) _Pragma("unroll") for (int k = 0; k < 2; ++k) \
        acc[ai][bj][m][n] = __builtin_amdgcn_mfma_f32_16x16x32_bf16(Bt[n][k], At[m][k], acc[ai][bj][m][n], 0, 0, 0); __builtin_amdgcn_s_setprio(0); } while (0)
#define PG8_WAIT_V(n) asm volatile("s_waitcnt vmcnt(" #n ")" ::: "memory")
#define PG8_WAIT_L(n) asm volatile("s_waitcnt lgkmcnt(" #n ")" ::: "memory")
#define PG8_BAR __builtin_amdgcn_s_barrier()
#define PG8_SCHED __builtin_amdgcn_sched_barrier(0)
    Unit cur, nxt; int ui = 0;
    if (!S.next(0, cur)) return;
    f32x4 acc[2][2][4][2];
#pragma unroll
    for (int a = 0; a < 2; ++a)
#pragma unroll
        for (int b = 0; b < 2; ++b)
#pragma unroll
            for (int m = 0; m < 4; ++m)
#pragma unroll
                for (int n = 0; n < 2; ++n) acc[a][b][m][n] = (f32x4){0.f, 0.f, 0.f, 0.f};
    bf16x8 At[4][2], B0[2][2], B1[2][2];
    bool csw = S.is_sw(cur);
    const char* cA = csw ? (const char*)g.Bt + (size_t)cur.pn * tstep : (const char*)g.A + (size_t)cur.pm * tstep;
    const char* cB = csw ? (const char*)g.A + (size_t)cur.pm * tstep : (const char*)g.Bt + (size_t)cur.pn * tstep;
    if constexpr (SP2) {
        PG8_STAGE(PG8_SB(0, 0), cB, voffB); PG8_STAGE(PG8_SB(0, 1), cB + hstep, voffB); PG8_STAGE(PG8_SA(0, 0), cA, voffA); PG8_STAGE(PG8_SA(0, 1), cA + hstep, voffA);
        if (wr == 1) PG8_BAR;
        PG8_WAIT_V(2); PG8_BAR;
        PG8_STAGE(PG8_SB(1, 0), cB + kstep, voffB); PG8_STAGE(PG8_SA(1, 0), cA + kstep, voffA); PG8_STAGE(PG8_SB(1, 1), cB + hstep + kstep, voffB);
        PG8_WAIT_V(6); PG8_BAR;
    } else {
    PG8_STAGE(PG8_SB(0, 0), cB, voffB); PG8_STAGE(PG8_SA(0, 0), cA, voffA); PG8_STAGE(PG8_SB(0, 1), cB + hstep, voffB); PG8_STAGE(PG8_SA(0, 1), cA + hstep, voffA);
    if (wr == 1) PG8_BAR;
    PG8_WAIT_V(4); PG8_BAR;
    PG8_STAGE(PG8_SB(1, 0), cB + kstep, voffB); PG8_STAGE(PG8_SA(1, 0), cA + kstep, voffA); PG8_STAGE(PG8_SB(1, 1), cB + hstep + kstep, voffB);
    PG8_WAIT_V(6); PG8_BAR;
    }
    for (;;) {
        const bool has_next = S.next(ui + 1, nxt);
        const bool nsw = has_next ? S.is_sw(nxt) : false;
        const char* nA = has_next ? (nsw ? (const char*)g.Bt + (size_t)nxt.pn * tstep : (const char*)g.A + (size_t)nxt.pm * tstep) : cA;
        const char* nB = has_next ? (nsw ? (const char*)g.A + (size_t)nxt.pm * tstep : (const char*)g.Bt + (size_t)nxt.pn * tstep) : cB;
        for (int t = 0; t < nt; t += 2) {
            const bool last = (t == nt - 2);
            const char* a1 = cA + (size_t)(t + 1) * kstep;
            const char* a2 = last ? nA : cA + (size_t)(t + 2) * kstep; const char* b2 = last ? nB : cB + (size_t)(t + 2) * kstep;
            const char* a3 = a2 + kstep; const char* b3 = b2 + kstep;
            if constexpr (SP2) {
            PG8_LDB(B0, 0, 0); PG8_LDB(B1, 0, 1); PG8_SCHED; PG8_LDA(At, 0, 0); PG8_STAGE(PG8_SA(1, 1), a1 + hstep, voffA);
            PG8_WAIT_V(8); PG8_WAIT_L(0); PG8_BAR; PG8_MMA(0, 0, At, B0); PG8_MMA(0, 1, At, B1); PG8_BAR; PG8_SCHED;
            PG8_LDA(At, 0, 1); PG8_STAGE(PG8_SB(0, 0), b2, voffB); PG8_STAGE(PG8_SB(0, 1), b2 + hstep, voffB); PG8_STAGE(PG8_SA(0, 0), a2, voffA);
            PG8_WAIT_V(8); PG8_WAIT_L(0); PG8_BAR; PG8_MMA(1, 0, At, B0); PG8_MMA(1, 1, At, B1); PG8_BAR; PG8_SCHED;
            PG8_LDB(B0, 1, 0); PG8_LDB(B1, 1, 1); PG8_SCHED; PG8_LDA(At, 1, 0); PG8_STAGE(PG8_SA(0, 1), a2 + hstep, voffA);
            PG8_WAIT_V(8); PG8_WAIT_L(0); PG8_BAR; PG8_MMA(0, 0, At, B0); PG8_MMA(0, 1, At, B1); PG8_BAR; PG8_SCHED;
            PG8_LDA(At, 1, 1); PG8_STAGE(PG8_SB(1, 0), b3, voffB); PG8_STAGE(PG8_SB(1, 1), b3 + hstep, voffB); PG8_STAGE(PG8_SA(1, 0), a3, voffA);
            PG8_WAIT_V(8); PG8_WAIT_L(0); PG8_BAR; PG8_MMA(1, 0, At, B0); PG8_MMA(1, 1, At, B1); PG8_BAR; PG8_SCHED;
            } else {
            PG8_LDB(B0, 0, 0); PG8_SCHED; PG8_LDA(At, 0, 0); PG8_STAGE(PG8_SA(1, 1), a1 + hstep, voffA);
            PG8_WAIT_L(8); PG8_BAR; PG8_WAIT_L(0); PG8_MMA(0, 0, At, B0); PG8_BAR; PG8_SCHED;
            PG8_LDB(B1, 0, 1); PG8_STAGE(PG8_SB(0, 0), b2, voffB);
            PG8_BAR; PG8_WAIT_L(0); PG8_MMA(0, 1, At, B1); PG8_BAR;
            PG8_LDA(At, 0, 1); PG8_STAGE(PG8_SA(0, 0), a2, voffA);
            PG8_BAR; PG8_WAIT_L(0); PG8_MMA(1, 0, At, B0); PG8_BAR; PG8_SCHED;
            PG8_STAGE(PG8_SB(0, 1), b2 + hstep, voffB);
            PG8_WAIT_V(6); PG8_BAR; PG8_MMA(1, 1, At, B1); PG8_BAR;
            PG8_LDB(B0, 1, 0); PG8_SCHED; PG8_LDA(At, 1, 0); PG8_STAGE(PG8_SA(0, 1), a2 + hstep, voffA);
            PG8_WAIT_L(8); PG8_BAR; PG8_WAIT_L(0); PG8_MMA(0, 0, At, B0); PG8_BAR; PG8_SCHED;
            PG8_LDB(B1, 1, 1); PG8_STAGE(PG8_SB(1, 0), b3, voffB);
            PG8_BAR; PG8_WAIT_L(0); PG8_MMA(0, 1, At, B1); PG8_BAR;
            PG8_LDA(At, 1, 1); PG8_STAGE(PG8_SA(1, 0), a3, voffA);
            PG8_BAR; PG8_WAIT_L(0); PG8_MMA(1, 0, At, B0); PG8_BAR; PG8_SCHED;
            PG8_STAGE(PG8_SB(1, 1), b3 + hstep, voffB);
            PG8_WAIT_V(6); PG8_BAR; PG8_MMA(1, 1, At, B1); PG8_BAR;
            }
        }
        if constexpr (ALIGN_EPI) { if (wr == 0) PG8_BAR; }
        E(acc, cur, csw, wr, wc, fr, fq);
        if (!has_next) break;
#pragma unroll
        for (int a = 0; a < 2; ++a)
#pragma unroll
            for (int b = 0; b < 2; ++b)
#pragma unroll
                for (int m = 0; m < 4; ++m)
#pragma unroll
                    for (int n = 0; n < 2; ++n) acc[a][b][m][n] = (f32x4){0.f, 0.f, 0.f, 0.f};
        cur = nxt; cA = nA; cB = nB; csw = nsw; ++ui;
        if constexpr (ALIGN_EPI) { if (wr == 1) PG8_BAR; }
    }
    PG8_WAIT_V(0);
    if constexpr (!ALIGN_EPI) { if (wr == 0) PG8_BAR; }
    PG8_BAR;
#undef PG8_SA
#undef PG8_SB
#undef PG8_STAGE
#undef PG8_LDA
#undef PG8_LDB
#undef PG8_MMA
#undef PG8_WAIT_V
#undef PG8_WAIT_L
#undef PG8_BAR
#undef PG8_SCHED
}
}

__device__ __forceinline__ void transpose_item(const float* __restrict__ W, int K, int N, bf16_t* __restrict__ WT, LAS float* scr, int item, int lane) {
    const int nblk = N >> 5, kb = item / nblk, nb = item - kb * nblk, k0 = kb * 64, n0 = nb * 32;
    float v[32];
#pragma unroll
    for (int i = 0; i < 32; ++i) { const int kk = 2 * i + (lane >> 5); v[i] = W[(size_t)(k0 + kk) * N + n0 + (lane & 31)]; }
#pragma unroll
    for (int i = 0; i < 32; ++i) { const int kk = 2 * i + (lane >> 5); scr[kk * 33 + (lane & 31)] = v[i]; }
    asm volatile("s_waitcnt lgkmcnt(0)" ::: "memory");
    const int c = lane & 7;
#pragma unroll
    for (int j = 0; j < 4; ++j) { const int n = (lane >> 3) + 8 * j; const LAS float* s = scr + (8 * c) * 33 + n;
        u32x4 o; o.x = pk2(s[0 * 33], s[1 * 33]); o.y = pk2(s[2 * 33], s[3 * 33]); o.z = pk2(s[4 * 33], s[5 * 33]); o.w = pk2(s[6 * 33], s[7 * 33]);
        *(u32x4*)(WT + (size_t)(n0 + n) * K + k0 + 8 * c) = o; }
    asm volatile("s_waitcnt lgkmcnt(0)" ::: "memory");
}

__device__ __forceinline__ void phase_prologue(PP P, LAS unsigned char* lds) {
    const int tid = TID(), lane = tid & 63, wave = tid >> 6;
    {
        LAS float* s = (LAS float*)lds;
        LAS float* red = (LAS float*)(lds + 40960);
        for (int i = tid; i < 5 * D; i += 512) { const int r = i / D, k = i - r * D; const float v = (r < 4) ? P->in[I_C][r * D + k] : P->in[I_CCTX][k]; s[i] = siluf_(v); }
        __syncthreads();
        for (int it = BID(); it < 256; it += gridDim.x) {
            const int l = it >> 7, col0 = (it & 127) * 96;
            const int cgp = tid % 24, kg = tid / 24;
            float acc[5][4];
#pragma unroll
            for (int r = 0; r < 5; ++r)
#pragma unroll
                for (int i = 0; i < 4; ++i) acc[r][i] = 0.f;
            if (kg < 21) {
                const float* wp = P->in[I_WMOD] + (size_t)l * D * NMOD + col0 + 4 * cgp;
#pragma unroll 7
                for (int k = kg; k < D; k += 21) {
                    const f32x4 w = *(const f32x4*)(wp + (size_t)k * NMOD);
#pragma unroll
                    for (int r = 0; r < 5; ++r) { const float sv = s[r * D + k]; acc[r][0] += sv * w[0]; acc[r][1] += sv * w[1]; acc[r][2] += sv * w[2]; acc[r][3] += sv * w[3]; }
                }
#pragma unroll
                for (int r = 0; r < 5; ++r)
#pragma unroll
                    for (int i = 0; i < 4; ++i) red[(kg * 24 + cgp) * 20 + r * 4 + i] = acc[r][i];
            }
            __syncthreads();
            if (tid < 480) {
                const int cg2 = tid / 20, ri = tid % 20, r = ri >> 2, i = ri & 3;
                float sum = 0.f;
                for (int k2 = 0; k2 < 21; ++k2) sum += red[(k2 * 24 + cg2) * 20 + ri];
                const int col = col0 + 4 * cg2 + i;
                ((float*)(P->ws + WS_MOD))[((size_t)l * 5 + r) * NMOD + col] = sum + P->in[I_BMOD][l * NMOD + col];
            }
            __syncthreads();
        }
    }
    {
        const int gw = BID() * 8 + wave, NGW = gridDim.x * 8;
        for (int idx = gw; idx < 2 * 1280; idx += NGW) {
            const int l = idx / 1280, rr = idx - l * 1280; const int L = rr < 1024 ? 1024 : 256; const int t = rr < 1024 ? rr : rr - 1024;
            const float tf = (float)t, t01 = tf / (float)(L - 1);
            float feat = 0.f;
            if (lane == 0) feat = t01;
            else if (lane <= 32) { const int bi = (lane - 1) & 15; const float band = 1e-4f + (float)bi * ((15.0f - 1e-4f) / 15.0f);
                const float ang = (6.283185307179586f / (float)L) * tf * band; feat = (lane <= 16) ? cosf(ang) : -sinf(ang); }
            const float* w1 = P->in[I_HYW1] + l * 33 * 64; const float* w2 = P->in[I_HYW2] + l * 64 * 64;
            float a1 = P->in[I_HYB1][l * 64 + lane];
            for (int i = 0; i < 33; ++i) a1 += __shfl(feat, i) * w1[i * 64 + lane];
            const float h1 = sinf(a1);
            float a2 = P->in[I_HYB2][l * 64 + lane];
            for (int i = 0; i < 64; ++i) a2 += __shfl(h1, i) * w2[i * 64 + lane];
            ((float*)(P->ws + WS_H2))[(size_t)idx * 64 + lane] = sinf(a2);
        }
    }
    {
        LAS float* scr = (LAS float*)(lds + wave * 8448);
        const int gw = BID() * 8 + wave, NGW = gridDim.x * 8;
        constexpr int I_IN = 32 * 384, I_BR = 16 * 64, I_OUT = 32 * 64, I_UP = 32 * 352, I_DN = 88 * 64, I_LAYER = I_IN + 2 * I_BR + I_OUT + I_UP + I_DN;
        for (int it = gw; it < 2 * I_LAYER; it += NGW) {
            const int l = it / I_LAYER; int r = it - l * I_LAYER;
            if (r < I_IN) { transpose_item(P->in[I_WIN] + (size_t)l * D * NPROJ, D, NPROJ, (bf16_t*)(P->ws + WS_WIN + l * SZ_WIN), scr, r, lane); continue; } r -= I_IN;
            if (r < I_BR) { transpose_item(P->in[I_WA] + (size_t)l * DA * D, DA, D, (bf16_t*)(P->ws + WS_WA + l * SZ_WBR), scr, r, lane); continue; } r -= I_BR;
            if (r < I_BR) { transpose_item(P->in[I_WB] + (size_t)l * DA * D, DA, D, (bf16_t*)(P->ws + WS_WB + l * SZ_WBR), scr, r, lane); continue; } r -= I_BR;
            if (r < I_OUT) { transpose_item(P->in[I_WOUT] + (size_t)l * D * D, D, D, (bf16_t*)(P->ws + WS_WOUT + l * SZ_WOUT), scr, r, lane); continue; } r -= I_OUT;
            if (r < I_UP) { transpose_item(P->in[I_WUP] + (size_t)l * D * NUP, D, NUP, (bf16_t*)(P->ws + WS_WUP + l * SZ_WUP), scr, r, lane); continue; } r -= I_UP;
            transpose_item(P->in[I_WDN] + (size_t)l * DFF * D, DFF, D, (bf16_t*)(P->ws + WS_WDN + l * SZ_WDN), scr, r, lane);
        }
    }
}

__device__ __forceinline__ void prenorm_rows(PP P) {
    const int tid_ = TID(), lane = tid_ & 63, gw = BID() * 8 + (tid_ >> 6), NGW = gridDim.x * 8;
    const float* mod = (const float*)(P->ws + WS_MOD);
    bf16_t* HB = (bf16_t*)(P->ws + WS_HB);
    for (int row = gw; row < NTOK; row += NGW) {
        const float* xr = (row < NCTX) ? P->in[I_XP] + (size_t)row * D : P->in[I_XS] + (size_t)(row - NCTX) * D;
        const int mr = (row < NCTX) ? 4 : ((row - NCTX) >> 10);
        const float* md = mod + (size_t)mr * NMOD;
        f32x4 v[8]; float ss = 0.f;
#pragma unroll
        for (int j = 0; j < 8; ++j) { v[j] = *(const f32x4*)(xr + 4 * lane + 256 * j); ss += v[j][0] * v[j][0] + v[j][1] * v[j][1] + v[j][2] * v[j][2] + v[j][3] * v[j][3]; }
        const float r = rsqrtf(wave_sum(ss) * (1.f / D) + EPS);
#pragma unroll
        for (int j = 0; j < 8; ++j) { const int c = 4 * lane + 256 * j;
            const f32x4 g = *(const f32x4*)(P->in[I_GPREMIX] + c), sh = *(const f32x4*)(md + c), sc = *(const f32x4*)(md + D + c);
            u32x2 o; o.x = pk2(v[j][0] * r * g[0] * (1.f + sc[0]) + sh[0], v[j][1] * r * g[1] * (1.f + sc[1]) + sh[1]);
            o.y = pk2(v[j][2] * r * g[2] * (1.f + sc[2]) + sh[2], v[j][3] * r * g[3] * (1.f + sc[3]) + sh[3]);
            *(u32x2*)(HB + (size_t)row * D + c) = o; }
    }
}
__device__ __forceinline__ void row_phase(PP P, int l, const bf16_t* Y, int which  ) {
    const int tid_ = TID(), lane = tid_ & 63, gw = BID() * 8 + (tid_ >> 6), NGW = gridDim.x * 8;
    const float* mod = (const float*)(P->ws + WS_MOD);
    bf16_t* HB = (bf16_t*)(P->ws + WS_HB);
    const float* gpost = (which == 0 ? P->in[I_GPOSTMIX] : P->in[I_GPOSTFFN]) + l * D;
    const bool do_h = (which == 0) || (l + 1 < 2);
    const int ln = (which == 0) ? l : l + 1;
    const float* gpre = (which == 0 ? P->in[I_GPREFFN] : P->in[I_GPREMIX]) + (do_h ? ln : 0) * D;
    for (int row = gw; row < NTOK; row += NGW) {
        const int mr = (row < NCTX) ? 4 : ((row - NCTX) >> 10);
        const float* md = mod + ((size_t)l * 5 + mr) * NMOD;
        const float* gt = md + (which == 0 ? 2 : 5) * D;
        const float* mdn = mod + ((size_t)(do_h ? ln : 0) * 5 + mr) * NMOD + (which == 0 ? 3 * D : 0);
        const float* xo = (l == 0 && which == 0) ? ((row < NCTX) ? P->in[I_XP] + (size_t)row * D : P->in[I_XS] + (size_t)(row - NCTX) * D) : P->out + (size_t)row * D;
        const bf16_t* yr = Y + (size_t)row * D;
        f32x4 y[8], x[8]; float ss = 0.f;
#pragma unroll
        for (int j = 0; j < 8; ++j) { { const u32x2 yb = *(const u32x2*)(yr + 4 * lane + 256 * j); y[j][0] = bflo(yb.x); y[j][1] = bfhi(yb.x); y[j][2] = bflo(yb.y); y[j][3] = bfhi(yb.y); } x[j] = *(const f32x4*)(xo + 4 * lane + 256 * j);
            ss += y[j][0] * y[j][0] + y[j][1] * y[j][1] + y[j][2] * y[j][2] + y[j][3] * y[j][3]; }
        const float r1 = rsqrtf(wave_sum(ss) * (1.f / D) + EPS);
        float ss2 = 0.f;
#pragma unroll
        for (int j = 0; j < 8; ++j) { const int c = 4 * lane + 256 * j; const f32x4 g = *(const f32x4*)(gpost + c), t = *(const f32x4*)(gt + c);
            x[j][0] += t[0] * (y[j][0] * r1 * g[0]); x[j][1] += t[1] * (y[j][1] * r1 * g[1]); x[j][2] += t[2] * (y[j][2] * r1 * g[2]); x[j][3] += t[3] * (y[j][3] * r1 * g[3]);
            *(f32x4*)(P->out + (size_t)row * D + c) = x[j];
            ss2 += x[j][0] * x[j][0] + x[j][1] * x[j][1] + x[j][2] * x[j][2] + x[j][3] * x[j][3]; }
        if (do_h) {
            const float r2 = rsqrtf(wave_sum(ss2) * (1.f / D) + EPS);
#pragma unroll
            for (int j = 0; j < 8; ++j) { const int c = 4 * lane + 256 * j;
                const f32x4 g = *(const f32x4*)(gpre + c), sh = *(const f32x4*)(mdn + c), sc = *(const f32x4*)(mdn + D + c);
                u32x2 o; o.x = pk2(x[j][0] * r2 * g[0] * (1.f + sc[0]) + sh[0], x[j][1] * r2 * g[1] * (1.f + sc[1]) + sh[1]);
                o.y = pk2(x[j][2] * r2 * g[2] * (1.f + sc[2]) + sh[2], x[j][3] * r2 * g[3] * (1.f + sc[3]) + sh[3]);
                *(u32x2*)(HB + (size_t)row * D + c) = o; }
        }
    }
}

__device__ __forceinline__ void filter_units(PP P, LAS unsigned char* lds) {
    const int tid = TID(), lane = tid & 63, wave = tid >> 6;
    LAS float* h3 = (LAS float*)lds;
    for (int u = BID(); u < 512; u += gridDim.x) {
        const int l = u >> 8, c0 = (u & 255) * 4;
        const float* w3 = P->in[I_HYW3] + (size_t)l * 64 * 4096;
        const int fr = lane & 15, fq = lane >> 4;
        const int qcol = (fr >> 3) * 2048 + ((fr >> 2) & 1) * 1024 + c0 + (fr & 3);
        const float dcq = fabsf(P->in[I_HYDEC][(l * 2 + (fr >> 3)) * 1024 + c0 + (fr & 3)]);
        bf16x8 bh[2], bl[2];
#pragma unroll
        for (int kk = 0; kk < 2; ++kk) {
            float wv[8];
#pragma unroll
            for (int j = 0; j < 8; ++j) wv[j] = w3[(size_t)(32 * kk + 8 * fq + j) * 4096 + qcol];
            u32x4 hi, lo;
            hi.x = pk2(wv[0], wv[1]); hi.y = pk2(wv[2], wv[3]); hi.z = pk2(wv[4], wv[5]); hi.w = pk2(wv[6], wv[7]);
            lo.x = pk2(wv[0] - bflo(hi.x), wv[1] - bfhi(hi.x)); lo.y = pk2(wv[2] - bflo(hi.y), wv[3] - bfhi(hi.y));
            lo.z = pk2(wv[4] - bflo(hi.z), wv[5] - bfhi(hi.z)); lo.w = pk2(wv[6] - bflo(hi.w), wv[7] - bfhi(hi.w));
            bh[kk] = __builtin_bit_cast(bf16x8, hi); bl[kk] = __builtin_bit_cast(bf16x8, lo);
        }
        for (int lv = 0; lv < 2; ++lv) {
            const int L = lv == 0 ? 1024 : 256; const int rowoff = lv == 0 ? 0 : 1024;
            const float invL1 = 1.f / (float)(L - 1);
            for (int tb = wave; tb < (L >> 4); tb += 8) {
                const int t0 = tb * 16;
                const float* hr = (const float*)(P->ws + WS_H2) + ((size_t)l * 1280 + rowoff + t0 + fr) * 64 + 8 * fq;
                f32x4 acc = (f32x4){0.f, 0.f, 0.f, 0.f};
#pragma unroll
                for (int kk = 0; kk < 2; ++kk) {
                    const f32x4 h0 = *(const f32x4*)(hr + 32 * kk), h1 = *(const f32x4*)(hr + 32 * kk + 4);
                    u32x4 hi, lo;
                    hi.x = pk2(h0[0], h0[1]); hi.y = pk2(h0[2], h0[3]); hi.z = pk2(h1[0], h1[1]); hi.w = pk2(h1[2], h1[3]);
                    lo.x = pk2(h0[0] - bflo(hi.x), h0[1] - bfhi(hi.x)); lo.y = pk2(h0[2] - bflo(hi.y), h0[3] - bfhi(hi.y));
                    lo.z = pk2(h1[0] - bflo(hi.z), h1[1] - bfhi(hi.z)); lo.w = pk2(h1[2] - bflo(hi.w), h1[3] - bfhi(hi.w));
                    const bf16x8 ah = __builtin_bit_cast(bf16x8, hi), al = __builtin_bit_cast(bf16x8, lo);
                    acc = __builtin_amdgcn_mfma_f32_16x16x32_bf16(ah, bh[kk], acc, 0, 0, 0);
                    acc = __builtin_amdgcn_mfma_f32_16x16x32_bf16(ah, bl[kk], acc, 0, 0, 0);
                    acc = __builtin_amdgcn_mfma_f32_16x16x32_bf16(al, bh[kk], acc, 0, 0, 0);
                }
#pragma unroll
                for (int rg = 0; rg < 4; ++rg) { const int t = t0 + fq * 4 + rg; h3[fr * 1024 + t] = acc[rg] * __expf(-((float)t * invL1) * dcq); }
            }
            __syncthreads();
            {
                const int order = wave >> 2, ci = wave & 3;
                const LAS float* hf = h3 + ((order * 2 + 0) * 4 + ci) * 1024; const LAS float* hb = h3 + ((order * 2 + 1) * 4 + ci) * 1024;
                float s = 0.f;
                for (int t = lane; t < L; t += 64) s += (t == 0) ? fabsf(hf[0] + hb[0]) : (fabsf(hf[t]) + fabsf(hb[t]));
                const float inv = 1.f / (wave_sum(s) + EPS);
                bf16_t* F = (bf16_t*)(P->ws + WS_FILT) + (size_t)l * FILT_L + (lv == 0 ? 0 : (size_t)2 * 1024 * 2048) + ((size_t)order * 1024 + c0 + ci) * (2 * L);
                for (int i = lane; i < 2 * L; i += 64) { const int lag = L - i;
                    float v; if (i == 0) v = 0.f; else if (lag > 0) v = hf[lag]; else if (lag == 0) v = hf[0] + hb[0]; else v = hb[-lag];
                    F[i] = f2bf(v * inv); }
            }
            __syncthreads();
        }
    }
}

__device__ __forceinline__ void scan_unit(PP P, int l, LAS unsigned char* lds, int path, int b, int h, int dir) {
    const int tid = TID(), lane = tid & 63, w = tid >> 6;
    const int L = path ? 1024 : 256, tb = path ? NCTX + b * 1024 : b * 256, nch = L >> 5;
    const bf16_t* proj = (const bf16_t*)(P->ws + WS_A);
    float* OP = (float*)(P->ws + WS_B + SZ_HYT) + (size_t)dir * NTOK * DA;
    const __amdgpu_buffer_rsrc_t ors = __builtin_amdgcn_make_buffer_rsrc((void*)OP, 0, (int)((size_t)NTOK * DA * 4), 0x00020000);
    constexpr int QB = 0, KB = 8704, KDT = 17408, VT0 = 27648, VTS = 10240, SB0 = 48128, SBS = 34816, ATT = 117760, GSUM = 120320, DEC = 122368;
    const int d = tid & 127, tg = tid >> 7;
    float lb = 0.f;
    if (l == 1) { const float x0 = P->in[I_LB][(0 * 2 + dir) * DA + h * 128 + d], x1 = P->in[I_LB][(1 * 2 + dir) * DA + h * 128 + d]; lb = __builtin_amdgcn_rcpf(1.f + __expf(x0 - x1)); }
    const float oml = 1.f - lb;
    const int et = w & 3, dtb = (w >> 2) * 4, fr = lane & 15, fq = lane >> 4;
    f32x4 st[2][4];
#pragma unroll
    for (int s2 = 0; s2 < 2; ++s2)
#pragma unroll
        for (int i = 0; i < 4; ++i) {
            st[s2][i] = (f32x4){0.f, 0.f, 0.f, 0.f};
            if (path) { const int dd = (dtb + i) * 16 + fq * 4, ee = s2 * 64 + et * 16 + fr;
                const float* sp = P->in[I_STATE] + ((((size_t)(b * 2 + l) * 2 + dir) * 8 + h) * 128 + dd) * 128 + ee;
                st[s2][i][0] = sp[0]; st[s2][i][1] = sp[128]; st[s2][i][2] = sp[256]; st[s2][i][3] = sp[384]; }
        }
    const int ve = tid & 127, vjg = tid >> 7;
    bf16_t qr[8], fz[8], vr[8], qr2[8], fz2[8], vr2[8];
    auto tokof = [&](int c, int j) { const int p = c * 32 + j; return tb + (dir ? (L - 1 - p) : p); };
    const __amdgpu_buffer_rsrc_t prs = __builtin_amdgcn_make_buffer_rsrc((void*)proj, 0, (int)((size_t)NTOK * NPROJ * 2), 0x00020000);
    const unsigned voff0 = (unsigned)(tb + (dir ? (L - 1 - (tg * 8 + 7)) : tg * 8)) * (unsigned)(NPROJ * 2) + (unsigned)((h * 128 + d) * 2);
    const int vstep = dir ? -(32 * NPROJ * 2) : (32 * NPROJ * 2);
    const int fcol = 2048 * (1 + dir);
    auto load_chunk = [&](int c, bf16_t (&q_)[8], bf16_t (&f_)[8], bf16_t (&v_)[8]) {
        const unsigned vo = voff0 + (unsigned)(c * vstep);
#pragma unroll
        for (int i = 0; i < 8; ++i) { const int ro = (dir ? (7 - i) : i) * (NPROJ * 2);
            q_[i] = __builtin_amdgcn_raw_buffer_load_b16(prs, vo, ro, 0); f_[i] = __builtin_amdgcn_raw_buffer_load_b16(prs, vo, ro + fcol, 0); v_[i] = __builtin_amdgcn_raw_buffer_load_b16(prs, vo, ro + 6144, 0); }
    };
    load_chunk(0, qr, fz, vr);
    load_chunk(1, qr2, fz2, vr2);
    float pre[8], kk[8];
    auto part1 = [&](int c) {
        const int SB = SB0 + (c & 1) * SBS, VT = VT0 + (c & 1) * VTS;
        float run = 0.f;
#pragma unroll
        for (int i = 0; i < 8; ++i) { const float z = bf2f(fz[i]); const float e = __expf(-fabsf(z)), r = __builtin_amdgcn_rcpf(1.f + e);
            const float sp = z >= 0.f ? r : e * r, sn = z >= 0.f ? e * r : r;
            run += __logf(lb + oml * sp); pre[i] = run; kk[i] = oml * sn; }
        ((LAS float*)(lds + GSUM))[tg * 128 + d] = run;
#pragma unroll
        for (int s2 = 0; s2 < 2; ++s2)
#pragma unroll
            for (int i = 0; i < 4; ++i) { u32x2 o; o.x = pk2(st[s2][i][0], st[s2][i][1]); o.y = pk2(st[s2][i][2], st[s2][i][3]);
                *(LAS u32x2*)(lds + SB + ((s2 * 64 + et * 16 + fr) * 136 + (dtb + i) * 16 + fq * 4) * 2) = o; }
        { u32x4 o; o.x = (unsigned)vr[0] | ((unsigned)vr[1] << 16); o.y = (unsigned)vr[2] | ((unsigned)vr[3] << 16); o.z = (unsigned)vr[4] | ((unsigned)vr[5] << 16); o.w = (unsigned)vr[6] | ((unsigned)vr[7] << 16);
          *(LAS u32x4*)(lds + VT + (ve * 40 + vjg * 8) * 2) = o; }
    };
    part1(0);
    LBAR();
#pragma unroll 1
    for (int c = 0; c < nch; ++c) {
        const int SB = SB0 + (c & 1) * SBS, VT = VT0 + (c & 1) * VTS;
        {
            const LAS float* gs = (const LAS float*)(lds + GSUM);
            const float g0 = gs[d], g1 = gs[128 + d], g2 = gs[256 + d], g3 = gs[384 + d];
            const float tot = g0 + g1 + g2 + g3;
            const float off = (tg == 0) ? 0.f : (tg == 1) ? g0 : (tg == 2) ? (g0 + g1) : (g0 + g1 + g2);
            const float etot = __expf(tot);
            float kd[8];
#pragma unroll
            for (int i = 0; i < 8; ++i) { const float bj = off + pre[i]; const int j = tg * 8 + i;
                const float q = bf2f(qr[i]); const float eb = __expf(bj), ebi = __expf(-bj);
                ((LAS bf16_t*)(lds + QB))[j * 136 + d] = f2bf(siluf_(q) * eb);
                const float kb = kk[i] * ebi;
                ((LAS bf16_t*)(lds + KB))[j * 136 + d] = f2bf(kb);
                kd[i] = kb * etot; }
            u32x4 o; o.x = pk2(kd[0], kd[1]); o.y = pk2(kd[2], kd[3]); o.z = pk2(kd[4], kd[5]); o.w = pk2(kd[6], kd[7]);
            *(LAS u32x4*)(lds + KDT + (d * 40 + tg * 8) * 2) = o;
            if (tg == 0) ((LAS float*)(lds + DEC))[d] = etot;
        }
        LBAR();
#pragma unroll
        for (int i = 0; i < 8; ++i) { qr[i] = qr2[i]; fz[i] = fz2[i]; vr[i] = vr2[i]; }
        if (c + 2 < nch) load_chunk(c + 2, qr2, fz2, vr2);
        const int tt = w >> 2;
        f32x4 acco[2];
#pragma unroll
        for (int s2 = 0; s2 < 2; ++s2) {
            acco[s2] = (f32x4){0.f, 0.f, 0.f, 0.f};
#pragma unroll
            for (int k4 = 0; k4 < 4; ++k4) {
                const bf16x8 a = *(const LAS bf16x8*)(lds + QB + ((tt * 16 + fr) * 136 + k4 * 32 + 8 * fq) * 2);
                const bf16x8 bb = *(const LAS bf16x8*)(lds + SB + ((s2 * 64 + et * 16 + fr) * 136 + k4 * 32 + 8 * fq) * 2);
                acco[s2] = __builtin_amdgcn_mfma_f32_16x16x32_bf16(a, bb, acco[s2], 0, 0, 0);
            }
        }
        if (w < 4) {
            const int tt2 = w >> 1, s2 = w & 1;
            f32x4 aa = (f32x4){0.f, 0.f, 0.f, 0.f};
            if (!(tt2 == 0 && s2 == 1)) {
#pragma unroll
                for (int k4 = 0; k4 < 4; ++k4) {
                    const bf16x8 a = *(const LAS bf16x8*)(lds + QB + ((tt2 * 16 + fr) * 136 + k4 * 32 + 8 * fq) * 2);
                    const bf16x8 bb = *(const LAS bf16x8*)(lds + KB + ((s2 * 16 + fr) * 136 + k4 * 32 + 8 * fq) * 2);
                    aa = __builtin_amdgcn_mfma_f32_16x16x32_bf16(a, bb, aa, 0, 0, 0);
                }
            }
#pragma unroll
            for (int rg = 0; rg < 4; ++rg) { const int t = tt2 * 16 + fq * 4 + rg, s = s2 * 16 + fr;
                ((LAS bf16_t*)(lds + ATT))[t * 40 + s] = f2bf(s <= t ? aa[rg] : 0.f); }
        }
#pragma unroll
        for (int s2 = 0; s2 < 2; ++s2) {
            const bf16x8 vb = *(const LAS bf16x8*)(lds + VT + ((s2 * 64 + et * 16 + fr) * 40 + 8 * fq) * 2);
#pragma unroll
            for (int i = 0; i < 4; ++i) {
                const f32x4 dv = *(const LAS f32x4*)(lds + DEC + ((dtb + i) * 16 + fq * 4) * 4);
                const bf16x8 ka = *(const LAS bf16x8*)(lds + KDT + (((dtb + i) * 16 + fr) * 40 + 8 * fq) * 2);
                const f32x4 s0 = st[s2][i] * dv;
                st[s2][i] = __builtin_amdgcn_mfma_f32_16x16x32_bf16(ka, vb, s0, 0, 0, 0);
            }
        }
        if (c + 1 < nch) part1(c + 1);
        LBAR();
        {
            const unsigned ovo = (unsigned)(tb + (dir ? (L - 1 - (c * 32 + tt * 16 + fq * 4 + 3)) : (c * 32 + tt * 16 + fq * 4))) * (unsigned)(DA * 4) + (unsigned)((h * 128 + et * 16 + fr) * 4);
            const bf16x8 a = *(const LAS bf16x8*)(lds + ATT + ((tt * 16 + fr) * 40 + 8 * fq) * 2);
#pragma unroll
            for (int s2 = 0; s2 < 2; ++s2) {
                const bf16x8 bb = *(const LAS bf16x8*)(lds + VT + ((s2 * 64 + et * 16 + fr) * 40 + 8 * fq) * 2);
                acco[s2] = __builtin_amdgcn_mfma_f32_16x16x32_bf16(a, bb, acco[s2], 0, 0, 0);
#pragma unroll
                for (int rg = 0; rg < 4; ++rg) __builtin_amdgcn_raw_buffer_store_b32(__float_as_uint(acco[s2][rg]), ors, ovo, (dir ? (3 - rg) : rg) * (DA * 4) + s2 * 256, 0);
            }
        }
    }
    LBAR();
    if (!path) {
        float* ns = P->out + (size_t)2 * NCTX * D;
#pragma unroll
        for (int s2 = 0; s2 < 2; ++s2)
#pragma unroll
            for (int i = 0; i < 4; ++i) { const int dd = (dtb + i) * 16 + fq * 4, ee = s2 * 64 + et * 16 + fr;
                float* sp = ns + ((((size_t)(b * 2 + l) * 2 + dir) * 8 + h) * 128 + dd) * 128 + ee;
                sp[0] = st[s2][i][0]; sp[128] = st[s2][i][1]; sp[256] = st[s2][i][2]; sp[384] = st[s2][i][3]; }
    }
}

struct HyRegs { u32x4 raw[3]; bf16_t prev[3], next[3]; u32x4 filt; };
__device__ __forceinline__ void hy_issue(PP P, int l, unsigned u, HyRegs& R) {
    const int tid = TID();
    const int lat = (int)(((u >> 8) + u) & 1u), c = (int)(u >> 1);
    const int L = lat ? 1024 : 256, TOK0 = lat ? NCTX : 0;
    const bf16_t* HYT = (const bf16_t*)(P->ws + WS_B);
    const int g8 = tid * 8, t = g8 & (L - 1);
#pragma unroll
    for (int sec = 0; sec < 3; ++sec) {
        const bf16_t* row = HYT + (size_t)(sec * 1024 + c) * NTOK + TOK0;
        R.raw[sec] = *(const u32x4*)(row + g8);
        R.prev[sec] = (t > 0) ? row[g8 - 1] : (bf16_t)0; R.next[sec] = (t + 8 < L) ? row[g8 + 8] : (bf16_t)0;
    }
    const bf16_t* F = (const bf16_t*)(P->ws + WS_FILT) + (size_t)l * FILT_L + (lat ? 0 : (size_t)2 * 1024 * 2048);
    const int NCH = 2 * L / 8;
    R.filt = (u32x4){0u, 0u, 0u, 0u};
    if (tid < 2 * NCH) { const int order = tid / NCH, j = tid - order * NCH; R.filt = *(const u32x4*)(F + ((size_t)order * 1024 + c) * (2 * L) + 8 * j); }
}
template <bool LAT>
__device__ __forceinline__ unsigned hyena_unit(PP P, int l, LAS unsigned char* lds, int c, HyRegs& R, unsigned* ctr, volatile LAS unsigned* qs) {
    constexpr int L = LAT ? 1024 : 256, NB = LAT ? 4 : 16, ZS = L + 136, RLEN = 2 * L + 136, TOK0 = LAT ? NCTX : 0;
    constexpr int SZ_Z = NB * ZS * 2, OFF_Z = 0, OFF_Z2 = SZ_Z, OFF_X1 = 2 * SZ_Z, OFF_X2 = OFF_X1 + 8192, OFF_R = OFF_X2 + 8192;
    const int tid = TID(), lane = tid & 63, w = tid >> 6, fr = lane & 15, fq = lane >> 4;
    bf16_t* OB = (bf16_t*)(P->ws + WS_OB);
    unsigned nreg = 0u;
    if (tid == 0) nreg = __hip_atomic_fetch_add(ctr, 1u, __ATOMIC_RELAXED, __HIP_MEMORY_SCOPE_AGENT);
    for (int i = tid; i < 2 * NB * 136; i += 512) { const int a = i / (NB * 136), r = (i / 136) % NB, p = i % 136; const int pos = p < 64 ? p : (L + p);
        ((LAS bf16_t*)(lds + (a ? OFF_Z2 : OFF_Z)))[r * ZS + pos] = 0; }
    {
        const int g8 = tid * 8, bb = g8 / L, t = g8 % L;
#pragma unroll
        for (int sec = 0; sec < 3; ++sec) {
            const int ch3 = sec * 1024 + c;
            const u32x4 raw = R.raw[sec];
            float x[10];
            x[0] = bf2f(R.prev[sec]); x[9] = bf2f(R.next[sec]);
            x[1] = bflo(raw.x); x[2] = bfhi(raw.x); x[3] = bflo(raw.y); x[4] = bfhi(raw.y); x[5] = bflo(raw.z); x[6] = bfhi(raw.z); x[7] = bflo(raw.w); x[8] = bfhi(raw.w);
            const float w0 = P->in[I_HYCW][(l * 3 + 0) * 3072 + ch3], w1 = P->in[I_HYCW][(l * 3 + 1) * 3072 + ch3], w2 = P->in[I_HYCW][(l * 3 + 2) * 3072 + ch3], bi = P->in[I_HYCB][l * 3072 + ch3];
            float y[8];
#pragma unroll
            for (int i = 0; i < 8; ++i) y[i] = w0 * x[i] + w1 * x[i + 1] + w2 * x[i + 2] + bi;
            u32x4 o; o.x = pk2(y[0], y[1]); o.y = pk2(y[2], y[3]); o.z = pk2(y[4], y[5]); o.w = pk2(y[6], y[7]);
            if (sec == 0) *(LAS u32x4*)(lds + OFF_Z + (bb * ZS + 64 + t) * 2) = o;
            else *(LAS u32x4*)(lds + (sec == 1 ? OFF_X1 : OFF_X2) + (bb * L + t) * 2) = o;
        }
    }
    {
        constexpr int NCH = 2 * L / 8;
        LAS bf16_t* Rl = (LAS bf16_t*)(lds + OFF_R);
        if (tid < 2 * NCH) { const int order = tid / NCH, j = tid - order * NCH;
            const u32x4 f = R.filt;
            *(LAS u32x4*)(lds + OFF_R + ((order * 2 + 0) * RLEN + 64 + 8 * j) * 2) = f;
            LAS bf16_t* r1 = Rl + (order * 2 + 1) * RLEN + 63 + 8 * j;
            r1[0] = (bf16_t)(f.x & 0xffffu); r1[1] = (bf16_t)(f.x >> 16); r1[2] = (bf16_t)(f.y & 0xffffu); r1[3] = (bf16_t)(f.y >> 16);
            r1[4] = (bf16_t)(f.z & 0xffffu); r1[5] = (bf16_t)(f.z >> 16); r1[6] = (bf16_t)(f.w & 0xffffu); r1[7] = (bf16_t)(f.w >> 16); }
        for (int i = tid; i < 4 * 136; i += 512) { const int oc = i / 136, q = i - oc * 136, cp = oc & 1; const int lo = 64 - cp;
            const int p = q < lo ? q : (2 * L + q); Rl[oc * RLEN + p] = 0; }
    }
    LBAR();
    unsigned un = 0xffffffffu;
#pragma unroll 1
    for (int order = 0; order < 2; ++order) {
        const int zin = order == 0 ? OFF_Z : OFF_Z2;
        const float bias = P->in[I_HYBIAS][(l * 2 + order) * 1024 + c];
        const int nb_ = LAT ? (fr & 3) : fr, m_ = LAT ? (fr >> 2) : 0;
        f32x4 acc2[2];
        acc2[0] = (f32x4){0.f, 0.f, 0.f, 0.f}; acc2[1] = (f32x4){0.f, 0.f, 0.f, 0.f};
        constexpr int TB = LAT ? 64 : 16, S0 = LAT ? -64 : 0, NIT = (L - S0) / 32;
        const int t0a = (w * 2) * TB;
        const int cp = fr & 1, p0 = L + 64 - (t0a - S0) - fr + 8 * fq;
        const LAS unsigned* rpa = (const LAS unsigned*)(lds + OFF_R + ((order * 2 + cp) * RLEN) * 2) + ((p0 - cp) >> 1);
        const LAS unsigned char* zp = lds + zin + (nb_ * ZS + 64 + S0 + 16 * m_ + 8 * fq) * 2;
        if constexpr (LAT) {
            u32x4 ap2, ap1;
            { const LAS unsigned* r2 = rpa - 32; const LAS unsigned* r1 = rpa - 16;
              ap2.x = r2[0]; ap2.y = r2[1]; ap2.z = r2[2]; ap2.w = r2[3]; ap1.x = r1[0]; ap1.y = r1[1]; ap1.z = r1[2]; ap1.w = r1[3]; }
#pragma unroll 2
            for (int it = 0; it < NIT; it += 2) {
                u32x4 a0, a1; const LAS unsigned* ra = rpa + it * 16;
                a0.x = ra[0]; a0.y = ra[1]; a0.z = ra[2]; a0.w = ra[3]; a1.x = ra[16]; a1.y = ra[17]; a1.z = ra[18]; a1.w = ra[19];
                const bf16x8 b0 = *(const LAS bf16x8*)(zp + it * 64), b1 = *(const LAS bf16x8*)(zp + it * 64 + 64);
                acc2[0] = __builtin_amdgcn_mfma_f32_16x16x32_bf16(__builtin_bit_cast(bf16x8, a0), b0, acc2[0], 0, 0, 0);
                acc2[1] = __builtin_amdgcn_mfma_f32_16x16x32_bf16(__builtin_bit_cast(bf16x8, ap2), b0, acc2[1], 0, 0, 0);
                acc2[0] = __builtin_amdgcn_mfma_f32_16x16x32_bf16(__builtin_bit_cast(bf16x8, a1), b1, acc2[0], 0, 0, 0);
                acc2[1] = __builtin_amdgcn_mfma_f32_16x16x32_bf16(__builtin_bit_cast(bf16x8, ap1), b1, acc2[1], 0, 0, 0);
                ap2 = a0; ap1 = a1;
            }
        } else {
#pragma unroll 2
            for (int it = 0; it < NIT; it += 2) {
                u32x4 av[2][2]; bf16x8 bv[2];
#pragma unroll
                for (int k = 0; k < 2; ++k) {
                    const LAS unsigned* ra = rpa + (it + k) * 16; const LAS unsigned* rb = ra - TB / 2;
                    av[k][0].x = ra[0]; av[k][0].y = ra[1]; av[k][0].z = ra[2]; av[k][0].w = ra[3];
                    av[k][1].x = rb[0]; av[k][1].y = rb[1]; av[k][1].z = rb[2]; av[k][1].w = rb[3];
                    bv[k] = *(const LAS bf16x8*)(zp + (it + k) * 64);
                }
#pragma unroll
                for (int k = 0; k < 2; ++k) {
                    acc2[0] = __builtin_amdgcn_mfma_f32_16x16x32_bf16(__builtin_bit_cast(bf16x8, av[k][0]), bv[k], acc2[0], 0, 0, 0);
                    acc2[1] = __builtin_amdgcn_mfma_f32_16x16x32_bf16(__builtin_bit_cast(bf16x8, av[k][1]), bv[k], acc2[1], 0, 0, 0);
                }
            }
        }
#pragma unroll
        for (int tb2 = 0; tb2 < 2; ++tb2) {
            const int t0 = t0a + tb2 * TB; const f32x4 acc = acc2[tb2];
            const int tq = t0 + 16 * m_ + fq * 4;
            const u32x2 zr = *(const LAS u32x2*)(lds + zin + (nb_ * ZS + 64 + tq) * 2);
            const u32x2 xr = *(const LAS u32x2*)(lds + (order == 0 ? OFF_X1 : OFF_X2) + (nb_ * L + tq) * 2);
            float r0 = bflo(xr.x) * (acc[0] + bias * bflo(zr.x)), r1 = bfhi(xr.x) * (acc[1] + bias * bfhi(zr.x));
            float r2 = bflo(xr.y) * (acc[2] + bias * bflo(zr.y)), r3 = bfhi(xr.y) * (acc[3] + bias * bfhi(zr.y));
            if (order == 0) { u32x2 o; o.x = pk2(r0, r1); o.y = pk2(r2, r3); *(LAS u32x2*)(lds + OFF_Z2 + (nb_ * ZS + 64 + tq) * 2) = o; }
            else { bf16_t* op = OB + (size_t)(TOK0 + nb_ * L + tq) * DA + c; op[0] = f2bf(r0); op[DA] = f2bf(r1); op[2 * DA] = f2bf(r2); op[3 * DA] = f2bf(r3); }
        }
        if (order == 0 && tid == 0) qs[0] = nreg;
        LBAR();
        if (order == 0) { un = qs[0]; if (un < 2048u) hy_issue(P, l, un, R); }
    }
    return un;
}

#ifndef DUP_SCAN
#define DUP_SCAN 0
#endif
#ifndef DUP_HY
#define DUP_HY 0
#endif
__device__ __forceinline__ void phase_mixers(PP P, int l, LAS unsigned char* lds) {
    for (int rep = 0; rep < 1 + DUP_SCAN; ++rep) {
    if (gridDim.x == 256) {
        const int bid = BID();
        if (bid < 64) scan_unit(P, l, lds, 1, bid >> 4, (bid >> 1) & 7, bid & 1);
        else { const int v = bid - 64; scan_unit(P, l, lds, 0, v >> 4, (v >> 1) & 7, v & 1);
               if (v < 64) { const int v2 = v + 192; scan_unit(P, l, lds, 0, v2 >> 4, (v2 >> 1) & 7, v2 & 1); } }
    } else {
        for (int slot = BID(); slot < 320; slot += gridDim.x) {
            if (slot < 64) scan_unit(P, l, lds, 1, slot >> 4, (slot >> 1) & 7, slot & 1);
            else { const int v = slot - 64; scan_unit(P, l, lds, 0, v >> 4, (v >> 1) & 7, v & 1); }
        }
    }
    __syncthreads();
    }
    unsigned* ctr = (unsigned*)(P->ws + WS_BAR) + 64 * l;
    volatile LAS unsigned* qs = (volatile LAS unsigned*)(lds + 131072 + 8);
    if (threadIdx.x == 0) qs[0] = __hip_atomic_fetch_add(ctr, 1u, __ATOMIC_RELAXED, __HIP_MEMORY_SCOPE_AGENT);
    __syncthreads();
    unsigned u = qs[0];
    __syncthreads();
    HyRegs R;
    if (u < 2048u) hy_issue(P, l, u, R);
    while (u < 2048u) {
        const int path = (int)(((u >> 8) + u) & 1u), c = (int)(u >> 1);
        u = path ? hyena_unit<true>(P, l, lds, c, R, ctr, qs) : hyena_unit<false>(P, l, lds, c, R, ctr, qs);
    }
}

__device__ __forceinline__ void phase_combine(PP P, int l) {
    const int tid_ = TID(), lane = tid_ & 63, gw = BID() * 8 + (tid_ >> 6), NGW = gridDim.x * 8;
    const float* OP = (const float*)(P->ws + WS_B + SZ_HYT);
    const bf16_t* proj = (const bf16_t*)(P->ws + WS_A);
    bf16_t* OA = (bf16_t*)(P->ws + WS_OA);
    const int li = lane & 31, half = lane >> 5;
    const f32x4 wn = *(const f32x4*)(P->in[I_HNORM] + l * 128 + 4 * li);
    for (int it = gw; it < NTOK * 4; it += NGW) {
        const int item = it * 2 + half, tok = item >> 3, h = item & 7;
        const size_t off = (size_t)tok * DA + h * 128 + 4 * li;
        f32x4 o = *(const f32x4*)(OP + off); const f32x4 o2 = *(const f32x4*)(OP + (size_t)NTOK * DA + off);
        o[0] += o2[0]; o[1] += o2[1]; o[2] += o2[2]; o[3] += o2[3];
        float ss = o[0] * o[0] + o[1] * o[1] + o[2] * o[2] + o[3] * o[3];
#pragma unroll
        for (int s = 1; s < 32; s <<= 1) ss += __shfl_xor(ss, s);
        const float r = rsqrtf(ss * (1.f / 128.f) + EPS);
        const u32x2 g = *(const u32x2*)(proj + (size_t)tok * NPROJ + 4096 + h * 128 + 4 * li);
        u32x2 out; out.x = pk2(o[0] * r * wn[0] * siluf_(bflo(g.x)), o[1] * r * wn[1] * siluf_(bfhi(g.x)));
        out.y = pk2(o[2] * r * wn[2] * siluf_(bflo(g.y)), o[3] * r * wn[3] * siluf_(bfhi(g.y)));
        *(u32x2*)(OA + off) = out;
    }
}

typedef float f32x2 __attribute__((ext_vector_type(2)));
template <bool LAT>
__device__ __forceinline__ void ffn_sweep2(const bf16_t* __restrict__ U, bf16_t* __restrict__ ACT, const float* __restrict__ cw, const float* __restrict__ cb,
                                           int tok0, int xstart, bool rup, bool rdn, int c2) {
    constexpr int NI = LAT ? 4 : 2, NK = LAT ? 3 : 1, W = LAT ? 64 : 256, GS = 4, NG = 32 / GS;
    f32x2 wa[NK][3], wv[NK][3];
#pragma unroll
    for (int ry = 0; ry < NK; ++ry)
#pragma unroll
        for (int kx = 0; kx < 3; ++kx) { const int ky = LAT ? ry : 1; const float* wp = cw + (size_t)(ky * 3 + kx) * NUP + c2;
            wa[ry][kx] = *(const f32x2*)wp; wv[ry][kx] = *(const f32x2*)(wp + DFF); }
    const f32x2 ba = *(const f32x2*)(cb + c2), bv = *(const f32x2*)(cb + DFF + c2);
    unsigned ca[GS + 2][NI], cv[GS + 2][NI], na[GS][NI], nv[GS][NI];
    auto ld = [&](int x, unsigned (&a)[NI], unsigned (&v)[NI]) {
#pragma unroll
        for (int i = 0; i < NI; ++i) {
            const int xi = LAT ? x : x + 32 * i;
            const bool ok = (xi >= 0) && (xi < W) && (!LAT || (i == 0 ? rup : (i == 3 ? rdn : true)));
            a[i] = 0u; v[i] = 0u;
            if (ok) { const size_t off = (size_t)(tok0 + (x - xstart) + (LAT ? (i - 1) * 64 : 32 * i)) * NUP + c2; a[i] = *(const unsigned*)(U + off); v[i] = *(const unsigned*)(U + off + DFF); }
        }
    };
#pragma unroll
    for (int k = 0; k < GS + 2; ++k) ld(xstart - 1 + k, ca[k], cv[k]);
#pragma unroll 1
    for (int g = 0; g < NG; ++g) {
        const int x = xstart + GS * g;
        if (g < NG - 1) {
#pragma unroll
            for (int k = 0; k < GS; ++k) ld(x + GS + 1 + k, na[k], nv[k]);
        }
#pragma unroll
        for (int st = 0; st < GS; ++st) {
#pragma unroll
            for (int o = 0; o < 2; ++o) {
                f32x2 sa = ba, sv = bv;
#pragma unroll
                for (int ry = 0; ry < NK; ++ry)
#pragma unroll
                    for (int kx = 0; kx < 3; ++kx) { const unsigned a = ca[st + kx][LAT ? (o + ry) : o], v = cv[st + kx][LAT ? (o + ry) : o];
                        sa += wa[ry][kx] * (f32x2){bflo(a), bfhi(a)}; sv += wv[ry][kx] * (f32x2){bflo(v), bfhi(v)}; }
                *(unsigned*)(ACT + (size_t)(tok0 + GS * g + st + (LAT ? 64 * o : 32 * o)) * DFF + c2) = pk2(siluf_(sa[0]) * sv[0], siluf_(sa[1]) * sv[1]);
            }
        }
#pragma unroll
        for (int i = 0; i < NI; ++i) { ca[0][i] = ca[GS][i]; ca[1][i] = ca[GS + 1][i]; cv[0][i] = cv[GS][i]; cv[1][i] = cv[GS + 1][i];
#pragma unroll
            for (int k = 0; k < GS; ++k) { ca[2 + k][i] = na[k][i]; cv[2 + k][i] = nv[k][i]; } }
    }
}
__device__ __forceinline__ void phase_ffnconv(PP P, int l) {
    const int tid = TID();
    const bf16_t* U = (const bf16_t*)(P->ws + WS_A);
    bf16_t* ACT = (bf16_t*)(P->ws + WS_B);
    const float* cw = P->in[I_FCW] + (size_t)l * 9 * NUP; const float* cb = P->in[I_FCB] + (size_t)l * NUP;
    for (int blk = BID(); blk < 256; blk += gridDim.x) {
        const int v = (gridDim.x == 256) ? ((blk & 7) * 32 + (blk >> 3)) : blk;
        const int lu = v >> 2, qt = v & 3;
        for (int idx = tid; idx < 1408; idx += 512) {
            if (idx < 704) { const int bb = lu >> 4, rp = (lu >> 1) & 7, xh = lu & 1, r = 2 * rp;
                ffn_sweep2<true>(U, ACT, cw, cb, NCTX + bb * 1024 + r * 64 + xh * 32, xh * 32, r > 0, r + 2 < 16, 2 * (qt * 704 + idx)); }
            else { const int bb = lu >> 2, sp = lu & 3;
                ffn_sweep2<false>(U, ACT, cw, cb, bb * 256 + sp * 64, sp * 64, true, true, 2 * (qt * 704 + idx - 704)); }
        }
    }
}

#define XB_TMO      128
#define XB_XCNT(j)  (256  + 64 * (j))
#define XB_XSUB(j)  (1280 + 64 * (j))
#define XB_XGEN(j)  (2304 + 64 * (j))
#define XB_TOP      3328
#define XB_TOPGEN   3392
#define XCD_BAR_WORDS 3456
#define XB_SPIN_CAP (1u << 18)
__device__ __forceinline__ unsigned xb_ld(unsigned* p)              { return __hip_atomic_load(p, __ATOMIC_RELAXED, __HIP_MEMORY_SCOPE_AGENT); }
__device__ __forceinline__ unsigned xb_add(unsigned* p, unsigned v) { return __hip_atomic_fetch_add(p, v, __ATOMIC_RELAXED, __HIP_MEMORY_SCOPE_AGENT); }
__device__ __forceinline__ unsigned xb_xcc_id() { return (unsigned)__builtin_amdgcn_s_getreg((3 << 11) | 20) & 0xFu; }
#define XB_SPIN(cond, bar) do { unsigned _sp = 0; while (cond) { __builtin_amdgcn_s_sleep(1); \
    if ((++_sp & 255u) == 0u) { if (xb_ld(&(bar)[XB_TMO])) break; if (_sp > XB_SPIN_CAP) { atomicAdd(&(bar)[XB_TMO], 1u); break; } } } } while (0)
struct XcdBarrier { unsigned* bar; unsigned x; volatile LAS unsigned* st; };
__device__ __forceinline__ XcdBarrier xcd_barrier_post(unsigned* bar, volatile LAS unsigned* st) {
    XcdBarrier b; b.bar = bar; b.x = xb_xcc_id(); b.st = st;
    if (threadIdx.x == 0) (void)xb_add(&bar[XB_XCNT(b.x)], 1u);
    return b;
}
__device__ __forceinline__ void xcd_barrier_complete(unsigned* bar, unsigned x, unsigned& nloc, unsigned& nx) {
    const unsigned G = gridDim.x * gridDim.y * gridDim.z;
    unsigned sum, cnt, mine, sp = 0u;
    for (;;) {
        sum = 0u; cnt = 0u; mine = 0u;
#pragma unroll
        for (unsigned j = 0; j < 16; ++j) { const unsigned c = xb_ld(&bar[XB_XCNT(j)]); sum += c; cnt += (c > 0u) ? 1u : 0u; mine = (j == x) ? c : mine; }
        if (sum == G) break;
        __builtin_amdgcn_s_sleep(1);
        if ((++sp & 255u) == 0u) { if (xb_ld(&bar[XB_TMO])) break; if (sp > XB_SPIN_CAP) { atomicAdd(&bar[XB_TMO], 1u); break; } }
    }
    nloc = mine > 0u ? mine : 1u; nx = cnt > 0u ? cnt : 1u;
}
__device__ __forceinline__ void xcd_barrier(const XcdBarrier& b) {
    asm volatile("s_waitcnt vmcnt(0)" ::: "memory");
    __syncthreads();
    if (threadIdx.x == 0) {
        unsigned* bar = b.bar;
        __builtin_amdgcn_s_waitcnt(0);
        unsigned nloc = b.st[0], nx = b.st[1];
        if (nloc == 0u) { xcd_barrier_complete(bar, b.x, nloc, nx); b.st[0] = nloc; b.st[1] = nx; }
        const unsigned old = xb_add(&bar[XB_XSUB(b.x)], 1u);
        const unsigned gen = old / nloc;
        if (old + 1u == (gen + 1u) * nloc) {
            __builtin_amdgcn_fence(__ATOMIC_RELEASE, "agent");
            asm volatile("s_waitcnt vmcnt(0)" ::: "memory");
            const unsigned og = xb_add(&bar[XB_TOP], 1u);
            const unsigned tg = og / nx;
            if (og + 1u == (tg + 1u) * nx) xb_add(&bar[XB_TOPGEN], 1u);
            else XB_SPIN(xb_ld(&bar[XB_TOPGEN]) == tg, bar);
            __builtin_amdgcn_fence(__ATOMIC_ACQUIRE, "agent");
            xb_add(&bar[XB_XGEN(b.x)], 1u);
            asm volatile("s_waitcnt vmcnt(0)" ::: "memory");
        } else {
            XB_SPIN(xb_ld(&bar[XB_XGEN(b.x)]) == gen, bar);
            __builtin_amdgcn_fence(__ATOMIC_ACQUIRE, "agent");
            asm volatile("s_waitcnt vmcnt(0)" ::: "memory");
        }
    }
    __syncthreads();
}

__device__ __forceinline__ void run_phase(PP P, int ph, LAS unsigned char* lds) {
    using namespace pg8;
#ifndef PMASK
#define PMASK 0xFFF
#endif
    if (ph == 0) { if (PMASK & 1) phase_prologue(P, lds); return; }
    if (ph == 1) { if (PMASK & 2) { prenorm_rows(P); filter_units(P, lds); } return; }
    const int l = (ph - 2) / 10, sp = (ph - 2) % 10;
    StaticOrder S;
    if (!((PMASK >> (2 + sp)) & 1)) return;
    switch (sp) {
    case 0: {
        Gemm g{(const bf16_t*)(P->ws + WS_HB), (const bf16_t*)(P->ws + WS_WIN + l * SZ_WIN), NTOK, NPROJ, D};
        S.init(NTOK, NPROJ, gridDim.x, BID(), 20, 32);
        Epi<EP_PROJ> E{(bf16_t*)(P->ws + WS_A), NPROJ, nullptr, nullptr, nullptr, (bf16_t*)(P->ws + WS_B)};
        gemm_phase(lds, g, S, E); break; }
    case 1: phase_mixers(P, l, lds); break;
    case 2: phase_combine(P, l); break;
    case 3: {
        Gemm ga{(const bf16_t*)(P->ws + WS_OA), (const bf16_t*)(P->ws + WS_WA + l * SZ_WBR), NTOK, D, DA};
        S.init(NTOK, D, gridDim.x, BID(), 0, 0);
        Epi<EP_BRA> Ea{(bf16_t*)(P->ws + WS_D), D, nullptr, (const bf16_t*)(P->ws + WS_A) + 8192, nullptr, nullptr};
        gemm_phase(lds, ga, S, Ea);
        Gemm gb{(const bf16_t*)(P->ws + WS_OB), (const bf16_t*)(P->ws + WS_WB + l * SZ_WBR), NTOK, D, DA};
        Epi<EP_BRB> Eb{(bf16_t*)(P->ws + WS_D + (size_t)NTOK * D * 2), D, nullptr, (const bf16_t*)(P->ws + WS_A) + 10240, (const bf16_t*)(P->ws + WS_D), nullptr};
        gemm_phase(lds, gb, S, Eb); break; }
    case 4: {
        Gemm g{(const bf16_t*)(P->ws + WS_D + (size_t)NTOK * D * 2), (const bf16_t*)(P->ws + WS_WOUT + l * SZ_WOUT), NTOK, D, D};
        S.init(NTOK, D, gridDim.x, BID(), 0, 0);
        Epi<EP_BF16> E{(bf16_t*)(P->ws + WS_B), D, nullptr, nullptr, nullptr, nullptr};
        gemm_phase(lds, g, S, E); break; }
    case 5: row_phase(P, l, (const bf16_t*)(P->ws + WS_B), 0); break;
    case 6: {
        Gemm g{(const bf16_t*)(P->ws + WS_HB), (const bf16_t*)(P->ws + WS_WUP + l * SZ_WUP), NTOK, NUP, D};
        S.init(NTOK, NUP, gridDim.x, BID(), 0, 0);
        Epi<EP_BF16> E{(bf16_t*)(P->ws + WS_A), NUP, nullptr, nullptr, nullptr, nullptr};
        gemm_phase(lds, g, S, E); break; }
    case 7: phase_ffnconv(P, l); break;
    case 8: {
        Gemm g{(const bf16_t*)(P->ws + WS_B), (const bf16_t*)(P->ws + WS_WDN + l * SZ_WDN), NTOK, D, DFF};
        S.init(NTOK, D, gridDim.x, BID(), 0, 0);
        Epi<EP_BF16> E{(bf16_t*)(P->ws + WS_D), D, nullptr, nullptr, nullptr, nullptr};
        gemm_phase(lds, g, S, E); break; }
    case 9: row_phase(P, l, (const bf16_t*)(P->ws + WS_D), 1); break;
    }
}

__global__ void __launch_bounds__(512, 2) fwd_kernel(Params Pv) {
    extern __shared__ __attribute__((aligned(16))) unsigned char shm[];
    PP P = (PP)__builtin_amdgcn_kernarg_segment_ptr();
    LAS unsigned char* lds = (LAS unsigned char*)shm;
    cg::grid_group grid = cg::this_grid();
    if (threadIdx.x < 4) ((LAS unsigned*)(lds + 131072))[threadIdx.x] = 0u;
    __syncthreads();
    (void)xcd_barrier_post((unsigned*)(P->ws + WS_BAR), (volatile LAS unsigned*)(lds + 131072));
#define PHASE_STEP(ph) do { if ((ph) >= P->ph_lo && (ph) < P->ph_hi) { \
        if ((ph) > P->ph_lo) { if (P->ph_hi > NPHASE) grid.sync(); else { XcdBarrier xb; xb.bar = (unsigned*)(P->ws + WS_BAR); xb.x = xb_xcc_id(); xb.st = (volatile LAS unsigned*)(lds + 131072); xcd_barrier(xb); } } \
        run_phase(P, (ph), lds); } } while (0)
    PHASE_STEP(0); PHASE_STEP(1); PHASE_STEP(2); PHASE_STEP(3); PHASE_STEP(4); PHASE_STEP(5); PHASE_STEP(6); PHASE_STEP(7); PHASE_STEP(8); PHASE_STEP(9); PHASE_STEP(10);
    PHASE_STEP(11); PHASE_STEP(12); PHASE_STEP(13); PHASE_STEP(14); PHASE_STEP(15); PHASE_STEP(16); PHASE_STEP(17); PHASE_STEP(18); PHASE_STEP(19); PHASE_STEP(20); PHASE_STEP(21);
#undef PHASE_STEP
}

extern "C" void kernel_launch(void* const* d_in, const int* in_sizes, int n_in, void* d_out, int out_size, void* d_ws, size_t ws_size, hipStream_t stream) {
    static int grid = 0;
    if (grid == 0) {
        if (n_in != 30 || ws_size < WS_END) { fprintf(stderr, "kernel_launch: expected 30 inputs and >= %zu bytes of workspace; got %d, %zu\n", (size_t)WS_END, n_in, ws_size); grid = -1; return; }
        int dev = 0, cus = 0, per_cu = 0;
        hipGetDevice(&dev); hipDeviceGetAttribute(&cus, hipDeviceAttributeMultiprocessorCount, dev);
        if (hipFuncSetAttribute((const void*)fwd_kernel, hipFuncAttributeMaxDynamicSharedMemorySize, LDS_BYTES) != hipSuccess) { fprintf(stderr, "kernel_launch: hipFuncSetAttribute failed\n"); grid = -1; return; }
        hipOccupancyMaxActiveBlocksPerMultiprocessor(&per_cu, (const void*)fwd_kernel, 512, LDS_BYTES);
        if (per_cu < 1) { fprintf(stderr, "kernel_launch: occupancy query reports %d blocks per CU\n", per_cu); per_cu = 1; }
        (void)hipGetLastError();
        grid = cus;
    }
    if (grid < 0) return;
    Params p{};
    for (int i = 0; i < 30; ++i) p.in[i] = (const float*)d_in[i];
    p.out = (float*)d_out; p.ws = (unsigned char*)d_ws;
    if (hipMemsetAsync((char*)d_ws + WS_BAR, 0, 16384, stream) != hipSuccess) { fprintf(stderr, "kernel_launch: memset of the barrier words failed\n"); return; }
#if PER_PHASE_LAUNCH
    for (int ph = 0; ph < NPHASE; ++ph) {
        p.ph_lo = ph; p.ph_hi = ph + 1;
        hipLaunchKernelGGL(fwd_kernel, dim3(grid), dim3(512), LDS_BYTES, stream, p);
    }
#else
    p.ph_lo = 0; p.ph_hi = NPHASE;
    void* args[] = {&p};
    hipError_t e = hipLaunchCooperativeKernel((const void*)fwd_kernel, dim3(grid), dim3(512), args, LDS_BYTES, stream);
    if (e != hipSuccess) fprintf(stderr, "cooperative launch failed: %s (grid %d)\n", hipGetErrorString(e), grid);
#endif
}
```

```cpp
#include <hip/hip_runtime.h>
#include <hip/hip_cooperative_groups.h>
#include <cstdio>
#include <cstdint>
namespace cg = cooperative_groups;

#ifndef PER_PHASE_LAUNCH
#define PER_PHASE_LAUNCH 0
#endif

#ifndef DUPMASK
#define DUPMASK 0
#endif
#define LAS __attribute__((address_space(3)))
typedef unsigned short bf16_t;
typedef short bf16x8 __attribute__((ext_vector_type(8)));
typedef float f32x4 __attribute__((ext_vector_type(4)));
typedef unsigned u32x4 __attribute__((ext_vector_type(4)));
typedef unsigned u32x2 __attribute__((ext_vector_type(2)));

constexpr int D = 2048, NTOK = 8192, NCTX = 4096, NPROJ = 12288, DA = 1024, DFF = 5632, NUP = 11264, NMOD = 12288;
constexpr float EPS = 1e-6f;
constexpr int LDS_BYTES = 131072 + 16;
constexpr int NPHASE = 22;

constexpr size_t SZ_WIN = (size_t)NPROJ * D * 2, SZ_WBR = (size_t)D * DA * 2, SZ_WOUT = (size_t)D * D * 2, SZ_WUP = (size_t)NUP * D * 2, SZ_WDN = (size_t)D * DFF * 2;
constexpr size_t WS_WIN = 0;
constexpr size_t WS_WA = WS_WIN + 2 * SZ_WIN;
constexpr size_t WS_WB = WS_WA + 2 * SZ_WBR;
constexpr size_t WS_WOUT = WS_WB + 2 * SZ_WBR;
constexpr size_t WS_WUP = WS_WOUT + 2 * SZ_WOUT;
constexpr size_t WS_WDN = WS_WUP + 2 * SZ_WUP;
constexpr size_t WS_MOD = WS_WDN + 2 * SZ_WDN;
constexpr size_t WS_H2 = WS_MOD + (size_t)2 * 5 * NMOD * 4;
constexpr size_t FILT_L = (size_t)2 * 1024 * 2048 + (size_t)2 * 1024 * 512;
constexpr size_t WS_FILT = WS_H2 + (size_t)2 * 1280 * 64 * 4;
constexpr size_t WS_HB = WS_FILT + 2 * FILT_L * 2;
constexpr size_t WS_OA = WS_HB + (size_t)NTOK * D * 2;
constexpr size_t WS_OB = WS_OA + (size_t)NTOK * DA * 2;
constexpr size_t WS_A = WS_OB + (size_t)NTOK * DA * 2;
constexpr size_t WS_B = WS_A + (size_t)NTOK * NPROJ * 2;
constexpr size_t SZ_HYT = (size_t)3072 * NTOK * 2;
constexpr size_t WS_D = WS_B + SZ_HYT + (size_t)2 * NTOK * DA * 4;
constexpr size_t WS_BAR = WS_D + (size_t)NTOK * D * 4;
constexpr size_t WS_END = WS_BAR + 16384;

struct Params {
    const float* in[30];
    float* out; unsigned char* ws;
    int ph_lo, ph_hi;
};
typedef const __attribute__((address_space(4))) Params* PP;
enum { I_XP = 0, I_XS, I_STATE, I_C, I_CCTX, I_WMOD, I_BMOD, I_GPREMIX, I_GPOSTMIX, I_GPREFFN, I_GPOSTFFN, I_WIN, I_LB, I_HNORM, I_HYCW, I_HYCB,
       I_HYW1, I_HYB1, I_HYW2, I_HYB2, I_HYW3, I_HYDEC, I_HYBIAS, I_WA, I_WB, I_WOUT, I_WUP, I_FCW, I_FCB, I_WDN };

__device__ __forceinline__ float bf2f(unsigned b) { return __uint_as_float(b << 16); }
__device__ __forceinline__ float bflo(unsigned w) { return __uint_as_float(w << 16); }
__device__ __forceinline__ float bfhi(unsigned w) { return __uint_as_float(w & 0xffff0000u); }
__device__ __forceinline__ unsigned pk2(float lo, float hi) { unsigned r; asm("v_cvt_pk_bf16_f32 %0, %1, %2" : "=v"(r) : "v"(lo), "v"(hi)); return r; }
__device__ __forceinline__ bf16_t f2bf(float f) { return (bf16_t)(pk2(f, 0.f) & 0xffffu); }
__device__ __forceinline__ float wave_sum(float v) {
#pragma unroll
    for (int o = 1; o < 64; o <<= 1) v += __shfl_xor(v, o);
    return v;
}
#define LBAR() do { asm volatile("s_waitcnt lgkmcnt(0)" ::: "memory"); __builtin_amdgcn_s_barrier(); asm volatile("" ::: "memory"); } while (0)
__device__ __forceinline__ int TID() { int t = threadIdx.x; asm volatile("" : "+v"(t)); return t; }
__device__ __forceinline__ int BID() { int b = blockIdx.x; asm volatile("" : "+s"(b)); return b; }
__device__ __forceinline__ float sigmoidf_(float z) { return __builtin_amdgcn_rcpf(1.f + __expf(-z)); }
__device__ __forceinline__ float siluf_(float z) { return z * __builtin_amdgcn_rcpf(1.f + __expf(-z)); }

namespace pg8 {
constexpr int BM = 256, BK = 64, HALF = 128, HTB = HALF * BK * 2, STAGE_BYTES = 8 * HTB, NXCD = 8, WGM = 8;
__host__ __device__ __forceinline__ int lds_byte(int r, int c) { const int st = (r >> 4) * 2 + (c >> 5), rr = r & 15, cc = c & 31, ob = rr * 64 + cc * 2; return st * 1024 + (ob ^ (((ob >> 9) & 1) << 5)); }
__host__ __device__ __forceinline__ void stage_rc(int b, int& R, int& C) { const int st = b / 1024, sb = b % 1024, swz = sb ^ (((sb >> 9) & 1) << 5); R = (st >> 1) * 16 + swz / 64; C = (st & 1) * 32 + (swz % 64) / 2; }
__host__ __device__ __forceinline__ int perm32(int rho) { const int n = rho >> 4, i = rho & 15; return 8 * (i >> 2) + 4 * n + (i & 3); }

struct Unit { int pm, pn; };
struct Gemm { const bf16_t* A; const bf16_t* Bt; int M, N, K; };

struct StaticOrder {
    int nM, nN, nwg, G, c, sw_lo, sw_hi;
    __device__ void init(int M, int N, int G_, int c_, int swlo, int swhi) { nM = M / BM; nN = N / BM; nwg = nM * nN; G = G_; c = c_; sw_lo = swlo; sw_hi = swhi; }
    __device__ bool next(int i, Unit& u) const {
        const long L = (long)i * G + c; if (L >= nwg) return false;
        int wgid = (int)L; { const int q = nwg / NXCD, r = nwg % NXCD, xcd = wgid % NXCD, off = wgid / NXCD; wgid = (xcd < r ? xcd * (q + 1) : r * (q + 1) + (xcd - r) * q) + off; }
        const int nig = WGM * nN, gid = wgid / nig, fm = gid * WGM, gsz = (nM - fm) < WGM ? (nM - fm) : WGM;
        u.pm = fm + ((wgid % nig) % gsz); u.pn = (wgid % nig) / gsz; return true;
    }
    __device__ __forceinline__ bool is_sw(const Unit& u) const { return u.pn >= sw_lo && u.pn < sw_hi; }
};

enum { EP_PROJ = 0, EP_BF16 = 1, EP_BRA = 2, EP_BRB = 3, EP_F32 = 4 };
template <int MODE> struct Epi {
    static constexpr bool PERM = (MODE != EP_F32);
    bf16_t* O; int ldc; float* C; const bf16_t* G; const bf16_t* T; bf16_t* HYT;
    __device__ __forceinline__ void operator()(const f32x4 (&acc)[2][2][4][2], const Unit& u, bool sw, int wr, int wc, int fr, int fq) const {
        if constexpr (MODE == EP_F32) {
            const int row0 = u.pm * BM + wr * 64 + fr, col0 = u.pn * BM + wc * 32 + 4 * fq;
#pragma unroll
            for (int ai = 0; ai < 2; ++ai)
#pragma unroll
                for (int m = 0; m < 4; ++m) { float* rowp = C + (size_t)(row0 + ai * HALF + m * 16) * ldc + col0;
#pragma unroll
                    for (int bj = 0; bj < 2; ++bj)
#pragma unroll
                        for (int n = 0; n < 2; ++n) *(f32x4*)(rowp + bj * HALF + n * 16) = acc[ai][bj][m][n]; }
        } else {
            if (MODE == EP_PROJ && sw) {
                const int ch0 = (u.pn - 20) * BM + wr * 64 + fr, tok0 = u.pm * BM + wc * 32 + 8 * fq;
#pragma unroll
                for (int ai = 0; ai < 2; ++ai)
#pragma unroll
                    for (int m = 0; m < 4; ++m) { bf16_t* rowp = HYT + (size_t)(ch0 + ai * HALF + m * 16) * NTOK + tok0;
#pragma unroll
                        for (int bj = 0; bj < 2; ++bj) { const f32x4 v0 = acc[ai][bj][m][0], v1 = acc[ai][bj][m][1];
                            u32x4 o; o.x = pk2(v0[0], v0[1]); o.y = pk2(v0[2], v0[3]); o.z = pk2(v1[0], v1[1]); o.w = pk2(v1[2], v1[3]);
                            *(u32x4*)(rowp + bj * HALF) = o; } }
                return;
            }
            const int row0 = u.pm * BM + wr * 64 + fr, col0 = u.pn * BM + wc * 32 + 8 * fq;
#pragma unroll
            for (int ai = 0; ai < 2; ++ai)
#pragma unroll
                for (int m = 0; m < 4; ++m) { const size_t r = (size_t)(row0 + ai * HALF + m * 16);
#pragma unroll
                    for (int bj = 0; bj < 2; ++bj) { f32x4 v0 = acc[ai][bj][m][0], v1 = acc[ai][bj][m][1]; const int cc = col0 + bj * HALF;
                        if constexpr (MODE == EP_BRA || MODE == EP_BRB) {
                            const u32x4 g = *(const u32x4*)(G + r * NPROJ + cc);
                            v0[0] *= sigmoidf_(bflo(g.x)); v0[1] *= sigmoidf_(bfhi(g.x)); v0[2] *= sigmoidf_(bflo(g.y)); v0[3] *= sigmoidf_(bfhi(g.y));
                            v1[0] *= sigmoidf_(bflo(g.z)); v1[1] *= sigmoidf_(bfhi(g.z)); v1[2] *= sigmoidf_(bflo(g.w)); v1[3] *= sigmoidf_(bfhi(g.w));
                        }
                        if constexpr (MODE == EP_BRB) {
                            const u32x4 t = *(const u32x4*)(T + r * ldc + cc);
                            v0[0] += bflo(t.x); v0[1] += bfhi(t.x); v0[2] += bflo(t.y); v0[3] += bfhi(t.y);
                            v1[0] += bflo(t.z); v1[1] += bfhi(t.z); v1[2] += bflo(t.w); v1[3] += bfhi(t.w);
                        }
                        u32x4 o; o.x = pk2(v0[0], v0[1]); o.y = pk2(v0[2], v0[3]); o.z = pk2(v1[0], v1[1]); o.w = pk2(v1[2], v1[3]);
                        *(u32x4*)(O + r * ldc + cc) = o; } }
        }
    }
};

#ifndef GEMM_SP2
#define GEMM_SP2 1
#endif
#ifndef GEMM_ALIGN
#define GEMM_ALIGN 1
#endif
template <class EpiT, bool ALIGN_EPI = (GEMM_ALIGN != 0), bool SP2 = (GEMM_SP2 != 0)>
__device__ __forceinline__ void gemm_phase(LAS unsigned char* lds, const Gemm g, const StaticOrder& S, const EpiT& E) {
    const int tid = TID(), wid = __builtin_amdgcn_readfirstlane(tid >> 6), lane = tid & 63, wr = wid >> 2, wc = wid & 3, fr = lane & 15, fq = lane >> 4;
    const int K = g.K, nt = K / BK;
    unsigned voffA[2], voffB[2];
#pragma unroll
    for (int i = 0; i < 2; ++i) { int R, C; stage_rc(tid * 16 + i * 8192, R, C); const int Rb = EpiT::PERM ? ((R & ~31) + perm32(R & 31)) : R;
        voffA[i] = (unsigned)(R * K + C) * 2u; voffB[i] = (unsigned)(Rb * K + C) * 2u; }
    const size_t kstep = (size_t)(BK * 2);
    const size_t hstep = (size_t)HALF * K * 2;
    const size_t tstep = 2 * hstep;
    const unsigned ldsw = (unsigned)wid * 1024u;
    const int aoff = lds_byte(wr * 64 + fr, fq * 8), boff = lds_byte(wc * 32 + fr, fq * 8);
#define PG8_SA(b, h) (((b) * 2 + (h)) * HTB)
#define PG8_SB(b, h) ((4 + (b) * 2 + (h)) * HTB)
#define PG8_STAGE(bufoff, gbase, voff) do { _Pragma("unroll") for (int _i = 0; _i < 2; ++_i) \
        __builtin_amdgcn_global_load_lds((const unsigned*)((const char*)(gbase) + (voff)[_i]), (LAS unsigned*)(lds + (bufoff) + ldsw + _i * 8192), 16, 0, 0); } while (0)
#define PG8_LDA(dst, b, h) do { _Pragma("unroll") for (int m = 0; m < 4; ++m) _Pragma("unroll") for (int k = 0; k < 2; ++k) dst[m][k] = *(const LAS bf16x8*)(lds + PG8_SA(b, h) + aoff + m * 2048 + k * 1024); } while (0)
#define PG8_LDB(dst, b, h) do { _Pragma("unroll") for (int n = 0; n < 2; ++n) _Pragma("unroll") for (int k = 0; k < 2; ++k) dst[n][k] = *(const LAS bf16x8*)(lds + PG8_SB(b, h) + boff + n * 2048 + k * 1024); } while (0)
#define PG8_MMA(ai, bj, At, Bt) do { __builtin_amdgcn_s_setprio(1); _Pragma("unroll") for (int m = 0; m < 4; ++m) _Pragma("unroll") for (int n = 0; n < 2; ++n) _Pragma("unroll") for (int k = 0; k < 2; ++k) \
        acc[ai][bj][m][n] = __builtin_amdgcn_mfma_f32_16x16x32_bf16(Bt[n][k], At[m][k], acc[ai][bj][m][n], 0, 0, 0); __builtin_amdgcn_s_setprio(0); } while (0)
#define PG8_WAIT_V(n) asm volatile("s_waitcnt vmcnt(" #n ")" ::: "memory")
#define PG8_WAIT_L(n) asm volatile("s_waitcnt lgkmcnt(" #n ")" ::: "memory")
#define PG8_WAIT_V8E(x) asm volatile("s_cmp_eq_u32 %0, 0\n\ts_cbranch_scc1 .Lw8_%=\n\ts_waitcnt vmcnt(24)\n\ts_branch .Lwe_%=\n.Lw8_%=:\n\ts_waitcnt vmcnt(8)\n.Lwe_%=:" :: "s"(x) : "memory", "scc")
#define PG8_BAR __builtin_amdgcn_s_barrier()
#define PG8_SCHED __builtin_amdgcn_sched_barrier(0)
    Unit cur, nxt; int ui = 0;
    if (!S.next(0, cur)) return;
    f32x4 acc[2][2][4][2];
#pragma unroll
    for (int a = 0; a < 2; ++a)
#pragma unroll
        for (int b = 0; b < 2; ++b)
#pragma unroll
            for (int m = 0; m < 4; ++m)
#pragma unroll
                for (int n = 0; n < 2; ++n) acc[a][b][m][n] = (f32x4){0.f, 0.f, 0.f, 0.f};
    bf16x8 At[4][2], B0[2][2], B1[2][2];
    bool csw = S.is_sw(cur);
    const char* cA = csw ? (const char*)g.Bt + (size_t)cur.pn * tstep : (const char*)g.A + (size_t)cur.pm * tstep;
    const char* cB = csw ? (const char*)g.A + (size_t)cur.pm * tstep : (const char*)g.Bt + (size_t)cur.pn * tstep;
    if constexpr (SP2) {
        PG8_STAGE(PG8_SB(0, 0), cB, voffB); PG8_STAGE(PG8_SB(0, 1), cB + hstep, voffB); PG8_STAGE(PG8_SA(0, 0), cA, voffA); PG8_STAGE(PG8_SA(0, 1), cA + hstep, voffA);
        if (wr == 1) PG8_BAR;
        PG8_WAIT_V(2); PG8_BAR;
        PG8_STAGE(PG8_SB(1, 0), cB + kstep, voffB); PG8_STAGE(PG8_SA(1, 0), cA + kstep, voffA); PG8_STAGE(PG8_SB(1, 1), cB + hstep + kstep, voffB);
        PG8_WAIT_V(6); PG8_BAR;
    } else {
    PG8_STAGE(PG8_SB(0, 0), cB, voffB); PG8_STAGE(PG8_SA(0, 0), cA, voffA); PG8_STAGE(PG8_SB(0, 1), cB + hstep, voffB); PG8_STAGE(PG8_SA(0, 1), cA + hstep, voffA);
    if (wr == 1) PG8_BAR;
    PG8_WAIT_V(4); PG8_BAR;
    PG8_STAGE(PG8_SB(1, 0), cB + kstep, voffB); PG8_STAGE(PG8_SA(1, 0), cA + kstep, voffA); PG8_STAGE(PG8_SB(1, 1), cB + hstep + kstep, voffB);
    PG8_WAIT_V(6); PG8_BAR;
    }
    for (;;) {
        const bool has_next = S.next(ui + 1, nxt);
        const bool nsw = has_next ? S.is_sw(nxt) : false;
        const char* nA = has_next ? (nsw ? (const char*)g.Bt + (size_t)nxt.pn * tstep : (const char*)g.A + (size_t)nxt.pm * tstep) : cA;
        const char* nB = has_next ? (nsw ? (const char*)g.A + (size_t)nxt.pm * tstep : (const char*)g.Bt + (size_t)nxt.pn * tstep) : cB;
        for (int t = 0; t < nt; t += 2) {
            const bool last = (t == nt - 2);
            const char* a1 = cA + (size_t)(t + 1) * kstep;
            const char* a2 = last ? nA : cA + (size_t)(t + 2) * kstep; const char* b2 = last ? nB : cB + (size_t)(t + 2) * kstep;
            const char* a3 = a2 + kstep; const char* b3 = b2 + kstep;
            if constexpr (SP2) {
            const int aei = __builtin_amdgcn_readfirstlane(((t == 0) && (ui > 0)) ? 1 : 0);
            PG8_LDB(B0, 0, 0); PG8_LDB(B1, 0, 1); PG8_SCHED; PG8_LDA(At, 0, 0); PG8_STAGE(PG8_SA(1, 1), a1 + hstep, voffA);
            PG8_WAIT_V8E(aei); PG8_WAIT_L(0); PG8_BAR; PG8_MMA(0, 0, At, B0); PG8_MMA(0, 1, At, B1); PG8_BAR; PG8_SCHED;
            PG8_LDA(At, 0, 1); PG8_STAGE(PG8_SB(0, 0), b2, voffB); PG8_STAGE(PG8_SB(0, 1), b2 + hstep, voffB); PG8_STAGE(PG8_SA(0, 0), a2, voffA);
            PG8_WAIT_V8E(aei); PG8_WAIT_L(0); PG8_BAR; PG8_MMA(1, 0, At, B0); PG8_MMA(1, 1, At, B1); PG8_BAR; PG8_SCHED;
            PG8_LDB(B0, 1, 0); PG8_LDB(B1, 1, 1); PG8_SCHED; PG8_LDA(At, 1, 0); PG8_STAGE(PG8_SA(0, 1), a2 + hstep, voffA);
            PG8_WAIT_V(8); PG8_WAIT_L(0); PG8_BAR; PG8_MMA(0, 0, At, B0); PG8_MMA(0, 1, At, B1); PG8_BAR; PG8_SCHED;
            PG8_LDA(At, 1, 1); PG8_STAGE(PG8_SB(1, 0), b3, voffB); PG8_STAGE(PG8_SB(1, 1), b3 + hstep, voffB); PG8_STAGE(PG8_SA(1, 0), a3, voffA);
            PG8_WAIT_V(8); PG8_WAIT_L(0); PG8_BAR; PG8_MMA(1, 0, At, B0); PG8_MMA(1, 1, At, B1); PG8_BAR; PG8_SCHED;
            } else {
            PG8_LDB(B0, 0, 0); PG8_SCHED; PG8_LDA(At, 0, 0); PG8_STAGE(PG8_SA(1, 1), a1 + hstep, voffA);
            PG8_WAIT_L(8); PG8_BAR; PG8_WAIT_L(0); PG8_MMA(0, 0, At, B0); PG8_BAR; PG8_SCHED;
            PG8_LDB(B1, 0, 1); PG8_STAGE(PG8_SB(0, 0), b2, voffB);
            PG8_BAR; PG8_WAIT_L(0); PG8_MMA(0, 1, At, B1); PG8_BAR;
            PG8_LDA(At, 0, 1); PG8_STAGE(PG8_SA(0, 0), a2, voffA);
            PG8_BAR; PG8_WAIT_L(0); PG8_MMA(1, 0, At, B0); PG8_BAR; PG8_SCHED;
            PG8_STAGE(PG8_SB(0, 1), b2 + hstep, voffB);
            PG8_WAIT_V(6); PG8_BAR; PG8_MMA(1, 1, At, B1); PG8_BAR;
            PG8_LDB(B0, 1, 0); PG8_SCHED; PG8_LDA(At, 1, 0); PG8_STAGE(PG8_SA(0, 1), a2 + hstep, voffA);
            PG8_WAIT_L(8); PG8_BAR; PG8_WAIT_L(0); PG8_MMA(0, 0, At, B0); PG8_BAR; PG8_SCHED;
            PG8_LDB(B1, 1, 1); PG8_STAGE(PG8_SB(1, 0), b3, voffB);
            PG8_BAR; PG8_WAIT_L(0); PG8_MMA(0, 1, At, B1); PG8_BAR;
            PG8_LDA(At, 1, 1); PG8_STAGE(PG8_SA(1, 0), a3, voffA);
            PG8_BAR; PG8_WAIT_L(0); PG8_MMA(1, 0, At, B0); PG8_BAR; PG8_SCHED;
            PG8_STAGE(PG8_SB(1, 1), b3 + hstep, voffB);
            PG8_WAIT_V(6); PG8_BAR; PG8_MMA(1, 1, At, B1); PG8_BAR;
            }
        }
        if constexpr (ALIGN_EPI) { if (wr == 0) PG8_BAR; }
        E(acc, cur, csw, wr, wc, fr, fq);
        if (!has_next) break;
#pragma unroll
        for (int a = 0; a < 2; ++a)
#pragma unroll
            for (int b = 0; b < 2; ++b)
#pragma unroll
                for (int m = 0; m < 4; ++m)
#pragma unroll
                    for (int n = 0; n < 2; ++n) acc[a][b][m][n] = (f32x4){0.f, 0.f, 0.f, 0.f};
        cur = nxt; cA = nA; cB = nB; csw = nsw; ++ui;
        if constexpr (ALIGN_EPI) { if (wr == 1) PG8_BAR; }
    }
    PG8_WAIT_V(0);
    if constexpr (!ALIGN_EPI) { if (wr == 0) PG8_BAR; }
    PG8_BAR;
#undef PG8_SA
#undef PG8_SB
#undef PG8_STAGE
#undef PG8_LDA
#undef PG8_LDB
#undef PG8_MMA
#undef PG8_WAIT_V
#undef PG8_WAIT_L
#undef PG8_WAIT_V8E
#undef PG8_BAR
#undef PG8_SCHED
}
}

__device__ __forceinline__ void transpose_item(const float* __restrict__ W, int K, int N, bf16_t* __restrict__ WT, LAS float* scr, int item, int lane) {
    const int nblk = N >> 5, kb = item / nblk, nb = item - kb * nblk, k0 = kb * 64, n0 = nb * 32;
    float v[32];
#pragma unroll
    for (int i = 0; i < 32; ++i) { const int kk = 2 * i + (lane >> 5); v[i] = W[(size_t)(k0 + kk) * N + n0 + (lane & 31)]; }
#pragma unroll
    for (int i = 0; i < 32; ++i) { const int kk = 2 * i + (lane >> 5); scr[kk * 33 + (lane & 31)] = v[i]; }
    asm volatile("s_waitcnt lgkmcnt(0)" ::: "memory");
    const int c = lane & 7;
#pragma unroll
    for (int j = 0; j < 4; ++j) { const int n = (lane >> 3) + 8 * j; const LAS float* s = scr + (8 * c) * 33 + n;
        u32x4 o; o.x = pk2(s[0 * 33], s[1 * 33]); o.y = pk2(s[2 * 33], s[3 * 33]); o.z = pk2(s[4 * 33], s[5 * 33]); o.w = pk2(s[6 * 33], s[7 * 33]);
        *(u32x4*)(WT + (size_t)(n0 + n) * K + k0 + 8 * c) = o; }
    asm volatile("s_waitcnt lgkmcnt(0)" ::: "memory");
}

__device__ __forceinline__ void phase_prologue(PP P, LAS unsigned char* lds) {
    const int tid = TID(), lane = tid & 63, wave = tid >> 6;
    {
        LAS float* s = (LAS float*)lds;
        LAS float* red = (LAS float*)(lds + 40960);
        for (int i = tid; i < 5 * D; i += 512) { const int r = i / D, k = i - r * D; const float v = (r < 4) ? P->in[I_C][r * D + k] : P->in[I_CCTX][k]; s[i] = siluf_(v); }
        __syncthreads();
        for (int it = BID(); it < 256; it += gridDim.x) {
            const int l = it >> 7, col0 = (it & 127) * 96;
            const int cgp = tid % 24, kg = tid / 24;
            float acc[5][4];
#pragma unroll
            for (int r = 0; r < 5; ++r)
#pragma unroll
                for (int i = 0; i < 4; ++i) acc[r][i] = 0.f;
            if (kg < 21) {
                const float* wp = P->in[I_WMOD] + (size_t)l * D * NMOD + col0 + 4 * cgp;
#pragma unroll 7
                for (int k = kg; k < D; k += 21) {
                    const f32x4 w = *(const f32x4*)(wp + (size_t)k * NMOD);
#pragma unroll
                    for (int r = 0; r < 5; ++r) { const float sv = s[r * D + k]; acc[r][0] += sv * w[0]; acc[r][1] += sv * w[1]; acc[r][2] += sv * w[2]; acc[r][3] += sv * w[3]; }
                }
#pragma unroll
                for (int r = 0; r < 5; ++r)
#pragma unroll
                    for (int i = 0; i < 4; ++i) red[(kg * 24 + cgp) * 20 + r * 4 + i] = acc[r][i];
            }
            __syncthreads();
            if (tid < 480) {
                const int cg2 = tid / 20, ri = tid % 20, r = ri >> 2, i = ri & 3;
                float sum = 0.f;
                for (int k2 = 0; k2 < 21; ++k2) sum += red[(k2 * 24 + cg2) * 20 + ri];
                const int col = col0 + 4 * cg2 + i;
                ((float*)(P->ws + WS_MOD))[((size_t)l * 5 + r) * NMOD + col] = sum + P->in[I_BMOD][l * NMOD + col];
            }
            __syncthreads();
        }
    }
    {
        const int gw = BID() * 8 + wave, NGW = gridDim.x * 8;
        for (int idx = gw; idx < 2 * 1280; idx += NGW) {
            const int l = idx / 1280, rr = idx - l * 1280; const int L = rr < 1024 ? 1024 : 256; const int t = rr < 1024 ? rr : rr - 1024;
            const float tf = (float)t, t01 = tf / (float)(L - 1);
            float feat = 0.f;
            if (lane == 0) feat = t01;
            else if (lane <= 32) { const int bi = (lane - 1) & 15; const float band = 1e-4f + (float)bi * ((15.0f - 1e-4f) / 15.0f);
                const float ang = (6.283185307179586f / (float)L) * tf * band; feat = (lane <= 16) ? cosf(ang) : -sinf(ang); }
            const float* w1 = P->in[I_HYW1] + l * 33 * 64; const float* w2 = P->in[I_HYW2] + l * 64 * 64;
            float a1 = P->in[I_HYB1][l * 64 + lane];
            for (int i = 0; i < 33; ++i) a1 += __shfl(feat, i) * w1[i * 64 + lane];
            const float h1 = sinf(a1);
            float a2 = P->in[I_HYB2][l * 64 + lane];
            for (int i = 0; i < 64; ++i) a2 += __shfl(h1, i) * w2[i * 64 + lane];
            ((float*)(P->ws + WS_H2))[(size_t)idx * 64 + lane] = sinf(a2);
        }
    }
    {
        LAS float* scr = (LAS float*)(lds + wave * 8448);
        const int gw = BID() * 8 + wave, NGW = gridDim.x * 8;
        constexpr int I_IN = 32 * 384, I_BR = 16 * 64, I_OUT = 32 * 64, I_UP = 32 * 352, I_DN = 88 * 64, I_LAYER = I_IN + 2 * I_BR + I_OUT + I_UP + I_DN;
        for (int it = gw; it < 2 * I_LAYER; it += NGW) {
            const int l = it / I_LAYER; int r = it - l * I_LAYER;
            if (r < I_IN) { transpose_item(P->in[I_WIN] + (size_t)l * D * NPROJ, D, NPROJ, (bf16_t*)(P->ws + WS_WIN + l * SZ_WIN), scr, r, lane); continue; } r -= I_IN;
            if (r < I_BR) { transpose_item(P->in[I_WA] + (size_t)l * DA * D, DA, D, (bf16_t*)(P->ws + WS_WA + l * SZ_WBR), scr, r, lane); continue; } r -= I_BR;
            if (r < I_BR) { transpose_item(P->in[I_WB] + (size_t)l * DA * D, DA, D, (bf16_t*)(P->ws + WS_WB + l * SZ_WBR), scr, r, lane); continue; } r -= I_BR;
            if (r < I_OUT) { transpose_item(P->in[I_WOUT] + (size_t)l * D * D, D, D, (bf16_t*)(P->ws + WS_WOUT + l * SZ_WOUT), scr, r, lane); continue; } r -= I_OUT;
            if (r < I_UP) { transpose_item(P->in[I_WUP] + (size_t)l * D * NUP, D, NUP, (bf16_t*)(P->ws + WS_WUP + l * SZ_WUP), scr, r, lane); continue; } r -= I_UP;
            transpose_item(P->in[I_WDN] + (size_t)l * DFF * D, DFF, D, (bf16_t*)(P->ws + WS_WDN + l * SZ_WDN), scr, r, lane);
        }
    }
}

__device__ __forceinline__ void prenorm_rows(PP P) {
    const int tid_ = TID(), lane = tid_ & 63, gw = BID() * 8 + (tid_ >> 6), NGW = gridDim.x * 8;
    const float* mod = (const float*)(P->ws + WS_MOD);
    bf16_t* HB = (bf16_t*)(P->ws + WS_HB);
    for (int row = gw; row < NTOK; row += NGW) {
        const float* xr = (row < NCTX) ? P->in[I_XP] + (size_t)row * D : P->in[I_XS] + (size_t)(row - NCTX) * D;
        const int mr = (row < NCTX) ? 4 : ((row - NCTX) >> 10);
        const float* md = mod + (size_t)mr * NMOD;
        f32x4 v[8]; float ss = 0.f;
#pragma unroll
        for (int j = 0; j < 8; ++j) { v[j] = *(const f32x4*)(xr + 4 * lane + 256 * j); ss += v[j][0] * v[j][0] + v[j][1] * v[j][1] + v[j][2] * v[j][2] + v[j][3] * v[j][3]; }
        const float r = rsqrtf(wave_sum(ss) * (1.f / D) + EPS);
#pragma unroll
        for (int j = 0; j < 8; ++j) { const int c = 4 * lane + 256 * j;
            const f32x4 g = *(const f32x4*)(P->in[I_GPREMIX] + c), sh = *(const f32x4*)(md + c), sc = *(const f32x4*)(md + D + c);
            u32x2 o; o.x = pk2(v[j][0] * r * g[0] * (1.f + sc[0]) + sh[0], v[j][1] * r * g[1] * (1.f + sc[1]) + sh[1]);
            o.y = pk2(v[j][2] * r * g[2] * (1.f + sc[2]) + sh[2], v[j][3] * r * g[3] * (1.f + sc[3]) + sh[3]);
            *(u32x2*)(HB + (size_t)row * D + c) = o; }
    }
}
__device__ __forceinline__ void row_phase(PP P, int l, const bf16_t* Y, int which  ) {
    const int tid_ = TID(), lane = tid_ & 63, gw = BID() * 8 + (tid_ >> 6), NGW = gridDim.x * 8;
    const float* mod = (const float*)(P->ws + WS_MOD);
    bf16_t* HB = (bf16_t*)(P->ws + WS_HB);
    const float* gpost = (which == 0 ? P->in[I_GPOSTMIX] : P->in[I_GPOSTFFN]) + l * D;
    const bool do_h = (which == 0) || (l + 1 < 2);
    const int ln = (which == 0) ? l : l + 1;
    const float* gpre = (which == 0 ? P->in[I_GPREFFN] : P->in[I_GPREMIX]) + (do_h ? ln : 0) * D;
    for (int row = gw; row < NTOK; row += NGW) {
        const int mr = (row < NCTX) ? 4 : ((row - NCTX) >> 10);
        const float* md = mod + ((size_t)l * 5 + mr) * NMOD;
        const float* gt = md + (which == 0 ? 2 : 5) * D;
        const float* mdn = mod + ((size_t)(do_h ? ln : 0) * 5 + mr) * NMOD + (which == 0 ? 3 * D : 0);
        const float* xo = (l == 0 && which == 0) ? ((row < NCTX) ? P->in[I_XP] + (size_t)row * D : P->in[I_XS] + (size_t)(row - NCTX) * D) : P->out + (size_t)row * D;
        const bf16_t* yr = Y + (size_t)row * D;
        f32x4 y[8], x[8]; float ss = 0.f;
#pragma unroll
        for (int j = 0; j < 8; ++j) { { const u32x2 yb = *(const u32x2*)(yr + 4 * lane + 256 * j); y[j][0] = bflo(yb.x); y[j][1] = bfhi(yb.x); y[j][2] = bflo(yb.y); y[j][3] = bfhi(yb.y); } x[j] = *(const f32x4*)(xo + 4 * lane + 256 * j);
            ss += y[j][0] * y[j][0] + y[j][1] * y[j][1] + y[j][2] * y[j][2] + y[j][3] * y[j][3]; }
        const float r1 = rsqrtf(wave_sum(ss) * (1.f / D) + EPS);
        float ss2 = 0.f;
#pragma unroll
        for (int j = 0; j < 8; ++j) { const int c = 4 * lane + 256 * j; const f32x4 g = *(const f32x4*)(gpost + c), t = *(const f32x4*)(gt + c);
            x[j][0] += t[0] * (y[j][0] * r1 * g[0]); x[j][1] += t[1] * (y[j][1] * r1 * g[1]); x[j][2] += t[2] * (y[j][2] * r1 * g[2]); x[j][3] += t[3] * (y[j][3] * r1 * g[3]);
            *(f32x4*)(P->out + (size_t)row * D + c) = x[j];
            ss2 += x[j][0] * x[j][0] + x[j][1] * x[j][1] + x[j][2] * x[j][2] + x[j][3] * x[j][3]; }
        if (do_h) {
            const float r2 = rsqrtf(wave_sum(ss2) * (1.f / D) + EPS);
#pragma unroll
            for (int j = 0; j < 8; ++j) { const int c = 4 * lane + 256 * j;
                const f32x4 g = *(const f32x4*)(gpre + c), sh = *(const f32x4*)(mdn + c), sc = *(const f32x4*)(mdn + D + c);
                u32x2 o; o.x = pk2(x[j][0] * r2 * g[0] * (1.f + sc[0]) + sh[0], x[j][1] * r2 * g[1] * (1.f + sc[1]) + sh[1]);
                o.y = pk2(x[j][2] * r2 * g[2] * (1.f + sc[2]) + sh[2], x[j][3] * r2 * g[3] * (1.f + sc[3]) + sh[3]);
                *(u32x2*)(HB + (size_t)row * D + c) = o; }
        }
    }
}

__device__ __forceinline__ void filter_units(PP P, LAS unsigned char* lds) {
    const int tid = TID(), lane = tid & 63, wave = tid >> 6;
    LAS float* h3 = (LAS float*)lds;
    for (int u = BID(); u < 512; u += gridDim.x) {
        const int l = u >> 8, c0 = (u & 255) * 4;
        const float* w3 = P->in[I_HYW3] + (size_t)l * 64 * 4096;
        const int fr = lane & 15, fq = lane >> 4;
        const int qcol = (fr >> 3) * 2048 + ((fr >> 2) & 1) * 1024 + c0 + (fr & 3);
        const float dcq = fabsf(P->in[I_HYDEC][(l * 2 + (fr >> 3)) * 1024 + c0 + (fr & 3)]);
        bf16x8 bh[2], bl[2];
#pragma unroll
        for (int kk = 0; kk < 2; ++kk) {
            float wv[8];
#pragma unroll
            for (int j = 0; j < 8; ++j) wv[j] = w3[(size_t)(32 * kk + 8 * fq + j) * 4096 + qcol];
            u32x4 hi, lo;
            hi.x = pk2(wv[0], wv[1]); hi.y = pk2(wv[2], wv[3]); hi.z = pk2(wv[4], wv[5]); hi.w = pk2(wv[6], wv[7]);
            lo.x = pk2(wv[0] - bflo(hi.x), wv[1] - bfhi(hi.x)); lo.y = pk2(wv[2] - bflo(hi.y), wv[3] - bfhi(hi.y));
            lo.z = pk2(wv[4] - bflo(hi.z), wv[5] - bfhi(hi.z)); lo.w = pk2(wv[6] - bflo(hi.w), wv[7] - bfhi(hi.w));
            bh[kk] = __builtin_bit_cast(bf16x8, hi); bl[kk] = __builtin_bit_cast(bf16x8, lo);
        }
        for (int lv = 0; lv < 2; ++lv) {
            const int L = lv == 0 ? 1024 : 256; const int rowoff = lv == 0 ? 0 : 1024;
            const float invL1 = 1.f / (float)(L - 1);
            for (int tb = wave; tb < (L >> 4); tb += 8) {
                const int t0 = tb * 16;
                const float* hr = (const float*)(P->ws + WS_H2) + ((size_t)l * 1280 + rowoff + t0 + fr) * 64 + 8 * fq;
                f32x4 acc = (f32x4){0.f, 0.f, 0.f, 0.f};
#pragma unroll
                for (int kk = 0; kk < 2; ++kk) {
                    const f32x4 h0 = *(const f32x4*)(hr + 32 * kk), h1 = *(const f32x4*)(hr + 32 * kk + 4);
                    u32x4 hi, lo;
                    hi.x = pk2(h0[0], h0[1]); hi.y = pk2(h0[2], h0[3]); hi.z = pk2(h1[0], h1[1]); hi.w = pk2(h1[2], h1[3]);
                    lo.x = pk2(h0[0] - bflo(hi.x), h0[1] - bfhi(hi.x)); lo.y = pk2(h0[2] - bflo(hi.y), h0[3] - bfhi(hi.y));
                    lo.z = pk2(h1[0] - bflo(hi.z), h1[1] - bfhi(hi.z)); lo.w = pk2(h1[2] - bflo(hi.w), h1[3] - bfhi(hi.w));
                    const bf16x8 ah = __builtin_bit_cast(bf16x8, hi), al = __builtin_bit_cast(bf16x8, lo);
                    acc = __builtin_amdgcn_mfma_f32_16x16x32_bf16(ah, bh[kk], acc, 0, 0, 0);
                    acc = __builtin_amdgcn_mfma_f32_16x16x32_bf16(ah, bl[kk], acc, 0, 0, 0);
                    acc = __builtin_amdgcn_mfma_f32_16x16x32_bf16(al, bh[kk], acc, 0, 0, 0);
                }
#pragma unroll
                for (int rg = 0; rg < 4; ++rg) { const int t = t0 + fq * 4 + rg; h3[fr * 1024 + t] = acc[rg] * __expf(-((float)t * invL1) * dcq); }
            }
            __syncthreads();
            {
                const int order = wave >> 2, ci = wave & 3;
                const LAS float* hf = h3 + ((order * 2 + 0) * 4 + ci) * 1024; const LAS float* hb = h3 + ((order * 2 + 1) * 4 + ci) * 1024;
                float s = 0.f;
                for (int t = lane; t < L; t += 64) s += (t == 0) ? fabsf(hf[0] + hb[0]) : (fabsf(hf[t]) + fabsf(hb[t]));
                const float inv = 1.f / (wave_sum(s) + EPS);
                bf16_t* F = (bf16_t*)(P->ws + WS_FILT) + (size_t)l * FILT_L + (lv == 0 ? 0 : (size_t)2 * 1024 * 2048) + ((size_t)order * 1024 + c0 + ci) * (2 * L);
                for (int i = lane; i < 2 * L; i += 64) { const int lag = L - i;
                    float v; if (i == 0) v = 0.f; else if (lag > 0) v = hf[lag]; else if (lag == 0) v = hf[0] + hb[0]; else v = hb[-lag];
                    F[i] = f2bf(v * inv); }
            }
            __syncthreads();
        }
    }
}

__device__ __forceinline__ void scan_unit(PP P, int l, LAS unsigned char* lds, int path, int b, int h, int dir) {
    const int tid = TID(), lane = tid & 63, w = tid >> 6;
    const int L = path ? 1024 : 256, tb = path ? NCTX + b * 1024 : b * 256, nch = L >> 5;
    const bf16_t* proj = (const bf16_t*)(P->ws + WS_A);
    float* OP = (float*)(P->ws + WS_B + SZ_HYT) + (size_t)dir * NTOK * DA;
    const __amdgpu_buffer_rsrc_t ors = __builtin_amdgcn_make_buffer_rsrc((void*)OP, 0, (int)((size_t)NTOK * DA * 4), 0x00020000);
    constexpr int QB = 0, KB = 8704, KDT = 17408, VT0 = 27648, VTS = 10240, SB0 = 48128, SBS = 34816, ATT = 117760, GSUM = 120320, DEC = 122368;
    const int d = tid & 127, tg = tid >> 7;
    float lb = 0.f;
    if (l == 1) { const float x0 = P->in[I_LB][(0 * 2 + dir) * DA + h * 128 + d], x1 = P->in[I_LB][(1 * 2 + dir) * DA + h * 128 + d]; lb = __builtin_amdgcn_rcpf(1.f + __expf(x0 - x1)); }
    const float oml = 1.f - lb;
    const int et = w & 3, dtb = (w >> 2) * 4, fr = lane & 15, fq = lane >> 4;
    f32x4 st[2][4];
#pragma unroll
    for (int s2 = 0; s2 < 2; ++s2)
#pragma unroll
        for (int i = 0; i < 4; ++i) {
            st[s2][i] = (f32x4){0.f, 0.f, 0.f, 0.f};
            if (path) { const int dd = (dtb + i) * 16 + fq * 4, ee = s2 * 64 + et * 16 + fr;
                const float* sp = P->in[I_STATE] + ((((size_t)(b * 2 + l) * 2 + dir) * 8 + h) * 128 + dd) * 128 + ee;
                st[s2][i][0] = sp[0]; st[s2][i][1] = sp[128]; st[s2][i][2] = sp[256]; st[s2][i][3] = sp[384]; }
        }
    const int ve = tid & 127, vjg = tid >> 7;
    bf16_t qr[8], fz[8], vr[8], qr2[8], fz2[8], vr2[8];
    auto tokof = [&](int c, int j) { const int p = c * 32 + j; return tb + (dir ? (L - 1 - p) : p); };
    const __amdgpu_buffer_rsrc_t prs = __builtin_amdgcn_make_buffer_rsrc((void*)proj, 0, (int)((size_t)NTOK * NPROJ * 2), 0x00020000);
    const unsigned voff0 = (unsigned)(tb + (dir ? (L - 1 - (tg * 8 + 7)) : tg * 8)) * (unsigned)(NPROJ * 2) + (unsigned)((h * 128 + d) * 2);
    const int vstep = dir ? -(32 * NPROJ * 2) : (32 * NPROJ * 2);
    const int fcol = 2048 * (1 + dir);
    auto load_chunk = [&](int c, bf16_t (&q_)[8], bf16_t (&f_)[8], bf16_t (&v_)[8]) {
        const unsigned vo = voff0 + (unsigned)(c * vstep);
#pragma unroll
        for (int i = 0; i < 8; ++i) { const int ro = (dir ? (7 - i) : i) * (NPROJ * 2);
            q_[i] = __builtin_amdgcn_raw_buffer_load_b16(prs, vo, ro, 0); f_[i] = __builtin_amdgcn_raw_buffer_load_b16(prs, vo, ro + fcol, 0); v_[i] = __builtin_amdgcn_raw_buffer_load_b16(prs, vo, ro + 6144, 0); }
    };
    load_chunk(0, qr, fz, vr);
    load_chunk(1, qr2, fz2, vr2);
    float pre[8], kk[8];
    auto part1 = [&](int c) {
        const int SB = SB0 + (c & 1) * SBS, VT = VT0 + (c & 1) * VTS;
        float run = 0.f;
#pragma unroll
        for (int i = 0; i < 8; ++i) { const float z = bf2f(fz[i]); const float e = __expf(-fabsf(z)), r = __builtin_amdgcn_rcpf(1.f + e);
            const float sp = z >= 0.f ? r : e * r, sn = z >= 0.f ? e * r : r;
            run += __logf(lb + oml * sp); pre[i] = run; kk[i] = oml * sn; }
        ((LAS float*)(lds + GSUM))[tg * 128 + d] = run;
#pragma unroll
        for (int s2 = 0; s2 < 2; ++s2)
#pragma unroll
            for (int i = 0; i < 4; ++i) { u32x2 o; o.x = pk2(st[s2][i][0], st[s2][i][1]); o.y = pk2(st[s2][i][2], st[s2][i][3]);
                *(LAS u32x2*)(lds + SB + ((s2 * 64 + et * 16 + fr) * 136 + (dtb + i) * 16 + fq * 4) * 2) = o; }
        { u32x4 o; o.x = (unsigned)vr[0] | ((unsigned)vr[1] << 16); o.y = (unsigned)vr[2] | ((unsigned)vr[3] << 16); o.z = (unsigned)vr[4] | ((unsigned)vr[5] << 16); o.w = (unsigned)vr[6] | ((unsigned)vr[7] << 16);
          *(LAS u32x4*)(lds + VT + (ve * 40 + vjg * 8) * 2) = o; }
    };
    part1(0);
    LBAR();
#pragma unroll 1
    for (int c = 0; c < nch; ++c) {
        const int SB = SB0 + (c & 1) * SBS, VT = VT0 + (c & 1) * VTS;
        {
            const LAS float* gs = (const LAS float*)(lds + GSUM);
            const float g0 = gs[d], g1 = gs[128 + d], g2 = gs[256 + d], g3 = gs[384 + d];
            const float tot = g0 + g1 + g2 + g3;
            const float off = (tg == 0) ? 0.f : (tg == 1) ? g0 : (tg == 2) ? (g0 + g1) : (g0 + g1 + g2);
            const float etot = __expf(tot);
            float kd[8];
#pragma unroll
            for (int i = 0; i < 8; ++i) { const float bj = off + pre[i]; const int j = tg * 8 + i;
                const float q = bf2f(qr[i]); const float eb = __expf(bj), ebi = __expf(-bj);
                ((LAS bf16_t*)(lds + QB))[j * 136 + d] = f2bf(siluf_(q) * eb);
                const float kb = kk[i] * ebi;
                ((LAS bf16_t*)(lds + KB))[j * 136 + d] = f2bf(kb);
                kd[i] = kb * etot; }
            u32x4 o; o.x = pk2(kd[0], kd[1]); o.y = pk2(kd[2], kd[3]); o.z = pk2(kd[4], kd[5]); o.w = pk2(kd[6], kd[7]);
            *(LAS u32x4*)(lds + KDT + (d * 40 + tg * 8) * 2) = o;
            if (tg == 0) ((LAS float*)(lds + DEC))[d] = etot;
        }
        LBAR();
#pragma unroll
        for (int i = 0; i < 8; ++i) { qr[i] = qr2[i]; fz[i] = fz2[i]; vr[i] = vr2[i]; }
        if (c + 2 < nch) load_chunk(c + 2, qr2, fz2, vr2);
        const int tt = w >> 2;
        f32x4 acco[2];
#pragma unroll
        for (int s2 = 0; s2 < 2; ++s2) {
            acco[s2] = (f32x4){0.f, 0.f, 0.f, 0.f};
#pragma unroll
            for (int k4 = 0; k4 < 4; ++k4) {
                const bf16x8 a = *(const LAS bf16x8*)(lds + QB + ((tt * 16 + fr) * 136 + k4 * 32 + 8 * fq) * 2);
                const bf16x8 bb = *(const LAS bf16x8*)(lds + SB + ((s2 * 64 + et * 16 + fr) * 136 + k4 * 32 + 8 * fq) * 2);
                acco[s2] = __builtin_amdgcn_mfma_f32_16x16x32_bf16(a, bb, acco[s2], 0, 0, 0);
            }
        }
        if (w < 4) {
            const int tt2 = w >> 1, s2 = w & 1;
            f32x4 aa = (f32x4){0.f, 0.f, 0.f, 0.f};
            if (!(tt2 == 0 && s2 == 1)) {
#pragma unroll
                for (int k4 = 0; k4 < 4; ++k4) {
                    const bf16x8 a = *(const LAS bf16x8*)(lds + QB + ((tt2 * 16 + fr) * 136 + k4 * 32 + 8 * fq) * 2);
                    const bf16x8 bb = *(const LAS bf16x8*)(lds + KB + ((s2 * 16 + fr) * 136 + k4 * 32 + 8 * fq) * 2);
                    aa = __builtin_amdgcn_mfma_f32_16x16x32_bf16(a, bb, aa, 0, 0, 0);
                }
            }
#pragma unroll
            for (int rg = 0; rg < 4; ++rg) { const int t = tt2 * 16 + fq * 4 + rg, s = s2 * 16 + fr;
                ((LAS bf16_t*)(lds + ATT))[t * 40 + s] = f2bf(s <= t ? aa[rg] : 0.f); }
        }
#pragma unroll
        for (int s2 = 0; s2 < 2; ++s2) {
            const bf16x8 vb = *(const LAS bf16x8*)(lds + VT + ((s2 * 64 + et * 16 + fr) * 40 + 8 * fq) * 2);
#pragma unroll
            for (int i = 0; i < 4; ++i) {
                const f32x4 dv = *(const LAS f32x4*)(lds + DEC + ((dtb + i) * 16 + fq * 4) * 4);
                const bf16x8 ka = *(const LAS bf16x8*)(lds + KDT + (((dtb + i) * 16 + fr) * 40 + 8 * fq) * 2);
                const f32x4 s0 = st[s2][i] * dv;
                st[s2][i] = __builtin_amdgcn_mfma_f32_16x16x32_bf16(ka, vb, s0, 0, 0, 0);
            }
        }
        if (c + 1 < nch) part1(c + 1);
        LBAR();
        {
            const unsigned ovo = (unsigned)(tb + (dir ? (L - 1 - (c * 32 + tt * 16 + fq * 4 + 3)) : (c * 32 + tt * 16 + fq * 4))) * (unsigned)(DA * 4) + (unsigned)((h * 128 + et * 16 + fr) * 4);
            const bf16x8 a = *(const LAS bf16x8*)(lds + ATT + ((tt * 16 + fr) * 40 + 8 * fq) * 2);
#pragma unroll
            for (int s2 = 0; s2 < 2; ++s2) {
                const bf16x8 bb = *(const LAS bf16x8*)(lds + VT + ((s2 * 64 + et * 16 + fr) * 40 + 8 * fq) * 2);
                acco[s2] = __builtin_amdgcn_mfma_f32_16x16x32_bf16(a, bb, acco[s2], 0, 0, 0);
#pragma unroll
                for (int rg = 0; rg < 4; ++rg) __builtin_amdgcn_raw_buffer_store_b32(__float_as_uint(acco[s2][rg]), ors, ovo, (dir ? (3 - rg) : rg) * (DA * 4) + s2 * 256, 0);
            }
        }
    }
    LBAR();
    if (!path) {
        float* ns = P->out + (size_t)2 * NCTX * D;
#pragma unroll
        for (int s2 = 0; s2 < 2; ++s2)
#pragma unroll
            for (int i = 0; i < 4; ++i) { const int dd = (dtb + i) * 16 + fq * 4, ee = s2 * 64 + et * 16 + fr;
                float* sp = ns + ((((size_t)(b * 2 + l) * 2 + dir) * 8 + h) * 128 + dd) * 128 + ee;
                sp[0] = st[s2][i][0]; sp[128] = st[s2][i][1]; sp[256] = st[s2][i][2]; sp[384] = st[s2][i][3]; }
    }
}

struct HyRegs { u32x4 raw[3]; bf16_t prev[3], next[3]; u32x4 filt; };
__device__ __forceinline__ void hy_issue(PP P, int l, unsigned u, HyRegs& R) {
    const int tid = TID();
    const int lat = (int)(((u >> 8) + u) & 1u), c = (int)(u >> 1);
    const int L = lat ? 1024 : 256, TOK0 = lat ? NCTX : 0;
    const bf16_t* HYT = (const bf16_t*)(P->ws + WS_B);
    const int g8 = tid * 8, t = g8 & (L - 1);
#pragma unroll
    for (int sec = 0; sec < 3; ++sec) {
        const bf16_t* row = HYT + (size_t)(sec * 1024 + c) * NTOK + TOK0;
        R.raw[sec] = *(const u32x4*)(row + g8);
        R.prev[sec] = (t > 0) ? row[g8 - 1] : (bf16_t)0; R.next[sec] = (t + 8 < L) ? row[g8 + 8] : (bf16_t)0;
    }
    const bf16_t* F = (const bf16_t*)(P->ws + WS_FILT) + (size_t)l * FILT_L + (lat ? 0 : (size_t)2 * 1024 * 2048);
    const int NCH = 2 * L / 8;
    R.filt = (u32x4){0u, 0u, 0u, 0u};
    if (tid < 2 * NCH) { const int order = tid / NCH, j = tid - order * NCH; R.filt = *(const u32x4*)(F + ((size_t)order * 1024 + c) * (2 * L) + 8 * j); }
}
template <bool LAT>
__device__ __forceinline__ unsigned hyena_unit(PP P, int l, LAS unsigned char* lds, int c, HyRegs& R, unsigned* ctr, volatile LAS unsigned* qs) {
    constexpr int L = LAT ? 1024 : 256, NB = LAT ? 4 : 16, ZS = L + 136, RLEN = 2 * L + 136, TOK0 = LAT ? NCTX : 0;
    constexpr int SZ_Z = NB * ZS * 2, OFF_Z = 0, OFF_Z2 = SZ_Z, OFF_X1 = 2 * SZ_Z, OFF_X2 = OFF_X1 + 8192, OFF_R = OFF_X2 + 8192;
    const int tid = TID(), lane = tid & 63, w = tid >> 6, fr = lane & 15, fq = lane >> 4;
    bf16_t* OB = (bf16_t*)(P->ws + WS_OB);
    unsigned nreg = 0u;
    if (tid == 0) nreg = __hip_atomic_fetch_add(ctr, 1u, __ATOMIC_RELAXED, __HIP_MEMORY_SCOPE_AGENT);
    for (int i = tid; i < 2 * NB * 136; i += 512) { const int a = i / (NB * 136), r = (i / 136) % NB, p = i % 136; const int pos = p < 64 ? p : (L + p);
        ((LAS bf16_t*)(lds + (a ? OFF_Z2 : OFF_Z)))[r * ZS + pos] = 0; }
    {
        const int g8 = tid * 8, bb = g8 / L, t = g8 % L;
#pragma unroll
        for (int sec = 0; sec < 3; ++sec) {
            const int ch3 = sec * 1024 + c;
            const u32x4 raw = R.raw[sec];
            float x[10];
            x[0] = bf2f(R.prev[sec]); x[9] = bf2f(R.next[sec]);
            x[1] = bflo(raw.x); x[2] = bfhi(raw.x); x[3] = bflo(raw.y); x[4] = bfhi(raw.y); x[5] = bflo(raw.z); x[6] = bfhi(raw.z); x[7] = bflo(raw.w); x[8] = bfhi(raw.w);
            const float w0 = P->in[I_HYCW][(l * 3 + 0) * 3072 + ch3], w1 = P->in[I_HYCW][(l * 3 + 1) * 3072 + ch3], w2 = P->in[I_HYCW][(l * 3 + 2) * 3072 + ch3], bi = P->in[I_HYCB][l * 3072 + ch3];
            float y[8];
#pragma unroll
            for (int i = 0; i < 8; ++i) y[i] = w0 * x[i] + w1 * x[i + 1] + w2 * x[i + 2] + bi;
            u32x4 o; o.x = pk2(y[0], y[1]); o.y = pk2(y[2], y[3]); o.z = pk2(y[4], y[5]); o.w = pk2(y[6], y[7]);
            if (sec == 0) *(LAS u32x4*)(lds + OFF_Z + (bb * ZS + 64 + t) * 2) = o;
            else *(LAS u32x4*)(lds + (sec == 1 ? OFF_X1 : OFF_X2) + (bb * L + t) * 2) = o;
        }
    }
    {
        constexpr int NCH = 2 * L / 8;
        LAS bf16_t* Rl = (LAS bf16_t*)(lds + OFF_R);
        if (tid < 2 * NCH) { const int order = tid / NCH, j = tid - order * NCH;
            const u32x4 f = R.filt;
            *(LAS u32x4*)(lds + OFF_R + ((order * 2 + 0) * RLEN + 64 + 8 * j) * 2) = f;
            LAS bf16_t* r1 = Rl + (order * 2 + 1) * RLEN + 63 + 8 * j;
            r1[0] = (bf16_t)(f.x & 0xffffu); r1[1] = (bf16_t)(f.x >> 16); r1[2] = (bf16_t)(f.y & 0xffffu); r1[3] = (bf16_t)(f.y >> 16);
            r1[4] = (bf16_t)(f.z & 0xffffu); r1[5] = (bf16_t)(f.z >> 16); r1[6] = (bf16_t)(f.w & 0xffffu); r1[7] = (bf16_t)(f.w >> 16); }
        for (int i = tid; i < 4 * 136; i += 512) { const int oc = i / 136, q = i - oc * 136, cp = oc & 1; const int lo = 64 - cp;
            const int p = q < lo ? q : (2 * L + q); Rl[oc * RLEN + p] = 0; }
    }
    LBAR();
    unsigned un = 0xffffffffu;
#pragma unroll 1
    for (int order = 0; order < 2; ++order) {
        const int zin = order == 0 ? OFF_Z : OFF_Z2;
        const float bias = P->in[I_HYBIAS][(l * 2 + order) * 1024 + c];
        const int nb_ = LAT ? (fr & 3) : fr, m_ = LAT ? (fr >> 2) : 0;
        f32x4 acc2[2];
        acc2[0] = (f32x4){0.f, 0.f, 0.f, 0.f}; acc2[1] = (f32x4){0.f, 0.f, 0.f, 0.f};
        constexpr int TB = LAT ? 64 : 16, S0 = LAT ? -64 : 0, NIT = (L - S0) / 32;
        const int t0a = (w * 2) * TB;
        const int cp = fr & 1, p0 = L + 64 - (t0a - S0) - fr + 8 * fq;
        const LAS unsigned* rpa = (const LAS unsigned*)(lds + OFF_R + ((order * 2 + cp) * RLEN) * 2) + ((p0 - cp) >> 1);
        const LAS unsigned char* zp = lds + zin + (nb_ * ZS + 64 + S0 + 16 * m_ + 8 * fq) * 2;
        if constexpr (LAT) {
            u32x4 ap2, ap1;
            { const LAS unsigned* r2 = rpa - 32; const LAS unsigned* r1 = rpa - 16;
              ap2.x = r2[0]; ap2.y = r2[1]; ap2.z = r2[2]; ap2.w = r2[3]; ap1.x = r1[0]; ap1.y = r1[1]; ap1.z = r1[2]; ap1.w = r1[3]; }
#pragma unroll 2
            for (int it = 0; it < NIT; it += 2) {
                u32x4 a0, a1; const LAS unsigned* ra = rpa + it * 16;
                a0.x = ra[0]; a0.y = ra[1]; a0.z = ra[2]; a0.w = ra[3]; a1.x = ra[16]; a1.y = ra[17]; a1.z = ra[18]; a1.w = ra[19];
                const bf16x8 b0 = *(const LAS bf16x8*)(zp + it * 64), b1 = *(const LAS bf16x8*)(zp + it * 64 + 64);
                acc2[0] = __builtin_amdgcn_mfma_f32_16x16x32_bf16(__builtin_bit_cast(bf16x8, a0), b0, acc2[0], 0, 0, 0);
                acc2[1] = __builtin_amdgcn_mfma_f32_16x16x32_bf16(__builtin_bit_cast(bf16x8, ap2), b0, acc2[1], 0, 0, 0);
                acc2[0] = __builtin_amdgcn_mfma_f32_16x16x32_bf16(__builtin_bit_cast(bf16x8, a1), b1, acc2[0], 0, 0, 0);
                acc2[1] = __builtin_amdgcn_mfma_f32_16x16x32_bf16(__builtin_bit_cast(bf16x8, ap1), b1, acc2[1], 0, 0, 0);
                ap2 = a0; ap1 = a1;
            }
        } else {
#pragma unroll 2
            for (int it = 0; it < NIT; it += 2) {
                u32x4 av[2][2]; bf16x8 bv[2];
#pragma unroll
                for (int k = 0; k < 2; ++k) {
                    const LAS unsigned* ra = rpa + (it + k) * 16; const LAS unsigned* rb = ra - TB / 2;
                    av[k][0].x = ra[0]; av[k][0].y = ra[1]; av[k][0].z = ra[2]; av[k][0].w = ra[3];
                    av[k][1].x = rb[0]; av[k][1].y = rb[1]; av[k][1].z = rb[2]; av[k][1].w = rb[3];
                    bv[k] = *(const LAS bf16x8*)(zp + (it + k) * 64);
                }
#pragma unroll
                for (int k = 0; k < 2; ++k) {
                    acc2[0] = __builtin_amdgcn_mfma_f32_16x16x32_bf16(__builtin_bit_cast(bf16x8, av[k][0]), bv[k], acc2[0], 0, 0, 0);
                    acc2[1] = __builtin_amdgcn_mfma_f32_16x16x32_bf16(__builtin_bit_cast(bf16x8, av[k][1]), bv[k], acc2[1], 0, 0, 0);
                }
            }
        }
#pragma unroll
        for (int tb2 = 0; tb2 < 2; ++tb2) {
            const int t0 = t0a + tb2 * TB; const f32x4 acc = acc2[tb2];
            const int tq = t0 + 16 * m_ + fq * 4;
            const u32x2 zr = *(const LAS u32x2*)(lds + zin + (nb_ * ZS + 64 + tq) * 2);
            const u32x2 xr = *(const LAS u32x2*)(lds + (order == 0 ? OFF_X1 : OFF_X2) + (nb_ * L + tq) * 2);
            float r0 = bflo(xr.x) * (acc[0] + bias * bflo(zr.x)), r1 = bfhi(xr.x) * (acc[1] + bias * bfhi(zr.x));
            float r2 = bflo(xr.y) * (acc[2] + bias * bflo(zr.y)), r3 = bfhi(xr.y) * (acc[3] + bias * bfhi(zr.y));
            if (order == 0) { u32x2 o; o.x = pk2(r0, r1); o.y = pk2(r2, r3); *(LAS u32x2*)(lds + OFF_Z2 + (nb_ * ZS + 64 + tq) * 2) = o; }
            else { bf16_t* op = OB + (size_t)(TOK0 + nb_ * L + tq) * DA + c; op[0] = f2bf(r0); op[DA] = f2bf(r1); op[2 * DA] = f2bf(r2); op[3 * DA] = f2bf(r3); }
        }
        if (order == 0 && tid == 0) qs[0] = nreg;
        LBAR();
        if (order == 0) { un = qs[0]; if (un < 2048u) hy_issue(P, l, un, R); }
    }
    return un;
}

#ifndef DUP_SCAN
#define DUP_SCAN 0
#endif
#ifndef DUP_HY
#define DUP_HY 0
#endif
__device__ __forceinline__ void phase_mixers(PP P, int l, LAS unsigned char* lds) {
    for (int rep = 0; rep < 1 + DUP_SCAN; ++rep) {
    if (gridDim.x == 256) {
        const int bid = BID();
        if (bid < 64) scan_unit(P, l, lds, 1, bid >> 4, (bid >> 1) & 7, bid & 1);
        else { const int v = bid - 64; scan_unit(P, l, lds, 0, v >> 4, (v >> 1) & 7, v & 1);
               if (v < 64) { const int v2 = v + 192; scan_unit(P, l, lds, 0, v2 >> 4, (v2 >> 1) & 7, v2 & 1); } }
    } else {
        for (int slot = BID(); slot < 320; slot += gridDim.x) {
            if (slot < 64) scan_unit(P, l, lds, 1, slot >> 4, (slot >> 1) & 7, slot & 1);
            else { const int v = slot - 64; scan_unit(P, l, lds, 0, v >> 4, (v >> 1) & 7, v & 1); }
        }
    }
    __syncthreads();
    }
    unsigned* ctr = (unsigned*)(P->ws + WS_BAR) + 64 * l;
    volatile LAS unsigned* qs = (volatile LAS unsigned*)(lds + 131072 + 8);
    if (threadIdx.x == 0) qs[0] = __hip_atomic_fetch_add(ctr, 1u, __ATOMIC_RELAXED, __HIP_MEMORY_SCOPE_AGENT);
    __syncthreads();
    unsigned u = qs[0];
    __syncthreads();
    HyRegs R;
    if (u < 2048u) hy_issue(P, l, u, R);
    while (u < 2048u) {
        const int path = (int)(((u >> 8) + u) & 1u), c = (int)(u >> 1);
        u = path ? hyena_unit<true>(P, l, lds, c, R, ctr, qs) : hyena_unit<false>(P, l, lds, c, R, ctr, qs);
    }
}

__device__ __forceinline__ void phase_combine(PP P, int l) {
    const int tid_ = TID(), lane = tid_ & 63, gw = BID() * 8 + (tid_ >> 6), NGW = gridDim.x * 8;
    const float* OP = (const float*)(P->ws + WS_B + SZ_HYT);
    const bf16_t* proj = (const bf16_t*)(P->ws + WS_A);
    bf16_t* OA = (bf16_t*)(P->ws + WS_OA);
    const int li = lane & 31, half = lane >> 5;
    const f32x4 wn = *(const f32x4*)(P->in[I_HNORM] + l * 128 + 4 * li);
    for (int it = gw; it < NTOK * 4; it += NGW) {
        const int item = it * 2 + half, tok = item >> 3, h = item & 7;
        const size_t off = (size_t)tok * DA + h * 128 + 4 * li;
        f32x4 o = *(const f32x4*)(OP + off); const f32x4 o2 = *(const f32x4*)(OP + (size_t)NTOK * DA + off);
        o[0] += o2[0]; o[1] += o2[1]; o[2] += o2[2]; o[3] += o2[3];
        float ss = o[0] * o[0] + o[1] * o[1] + o[2] * o[2] + o[3] * o[3];
#pragma unroll
        for (int s = 1; s < 32; s <<= 1) ss += __shfl_xor(ss, s);
        const float r = rsqrtf(ss * (1.f / 128.f) + EPS);
        const u32x2 g = *(const u32x2*)(proj + (size_t)tok * NPROJ + 4096 + h * 128 + 4 * li);
        u32x2 out; out.x = pk2(o[0] * r * wn[0] * siluf_(bflo(g.x)), o[1] * r * wn[1] * siluf_(bfhi(g.x)));
        out.y = pk2(o[2] * r * wn[2] * siluf_(bflo(g.y)), o[3] * r * wn[3] * siluf_(bfhi(g.y)));
        *(u32x2*)(OA + off) = out;
    }
}

typedef float f32x2 __attribute__((ext_vector_type(2)));
template <bool LAT>
__device__ __forceinline__ void ffn_sweep2(const bf16_t* __restrict__ U, bf16_t* __restrict__ ACT, const float* __restrict__ cw, const float* __restrict__ cb,
                                           int tok0, int xstart, bool rup, bool rdn, int c2) {
    constexpr int NI = LAT ? 4 : 2, NK = LAT ? 3 : 1, W = LAT ? 64 : 256, GS = 4, NG = 32 / GS;
    f32x2 wa[NK][3], wv[NK][3];
#pragma unroll
    for (int ry = 0; ry < NK; ++ry)
#pragma unroll
        for (int kx = 0; kx < 3; ++kx) { const int ky = LAT ? ry : 1; const float* wp = cw + (size_t)(ky * 3 + kx) * NUP + c2;
            wa[ry][kx] = *(const f32x2*)wp; wv[ry][kx] = *(const f32x2*)(wp + DFF); }
    const f32x2 ba = *(const f32x2*)(cb + c2), bv = *(const f32x2*)(cb + DFF + c2);
    unsigned ca[GS + 2][NI], cv[GS + 2][NI], na[GS][NI], nv[GS][NI];
    auto ld = [&](int x, unsigned (&a)[NI], unsigned (&v)[NI]) {
#pragma unroll
        for (int i = 0; i < NI; ++i) {
            const int xi = LAT ? x : x + 32 * i;
            const bool ok = (xi >= 0) && (xi < W) && (!LAT || (i == 0 ? rup : (i == 3 ? rdn : true)));
            a[i] = 0u; v[i] = 0u;
            if (ok) { const size_t off = (size_t)(tok0 + (x - xstart) + (LAT ? (i - 1) * 64 : 32 * i)) * NUP + c2; a[i] = *(const unsigned*)(U + off); v[i] = *(const unsigned*)(U + off + DFF); }
        }
    };
#pragma unroll
    for (int k = 0; k < GS + 2; ++k) ld(xstart - 1 + k, ca[k], cv[k]);
#pragma unroll 1
    for (int g = 0; g < NG; ++g) {
        const int x = xstart + GS * g;
        if (g < NG - 1) {
#pragma unroll
            for (int k = 0; k < GS; ++k) ld(x + GS + 1 + k, na[k], nv[k]);
        }
#pragma unroll
        for (int st = 0; st < GS; ++st) {
#pragma unroll
            for (int o = 0; o < 2; ++o) {
                f32x2 sa = ba, sv = bv;
#pragma unroll
                for (int ry = 0; ry < NK; ++ry)
#pragma unroll
                    for (int kx = 0; kx < 3; ++kx) { const unsigned a = ca[st + kx][LAT ? (o + ry) : o], v = cv[st + kx][LAT ? (o + ry) : o];
                        sa += wa[ry][kx] * (f32x2){bflo(a), bfhi(a)}; sv += wv[ry][kx] * (f32x2){bflo(v), bfhi(v)}; }
                *(unsigned*)(ACT + (size_t)(tok0 + GS * g + st + (LAT ? 64 * o : 32 * o)) * DFF + c2) = pk2(siluf_(sa[0]) * sv[0], siluf_(sa[1]) * sv[1]);
            }
        }
#pragma unroll
        for (int i = 0; i < NI; ++i) { ca[0][i] = ca[GS][i]; ca[1][i] = ca[GS + 1][i]; cv[0][i] = cv[GS][i]; cv[1][i] = cv[GS + 1][i];
#pragma unroll
            for (int k = 0; k < GS; ++k) { ca[2 + k][i] = na[k][i]; cv[2 + k][i] = nv[k][i]; } }
    }
}
__device__ __forceinline__ void phase_ffnconv(PP P, int l) {
    const int tid = TID();
    const bf16_t* U = (const bf16_t*)(P->ws + WS_A);
    bf16_t* ACT = (bf16_t*)(P->ws + WS_B);
    const float* cw = P->in[I_FCW] + (size_t)l * 9 * NUP; const float* cb = P->in[I_FCB] + (size_t)l * NUP;
    for (int blk = BID(); blk < 256; blk += gridDim.x) {
        const int v = (gridDim.x == 256) ? ((blk & 7) * 32 + (blk >> 3)) : blk;
        const int lu = v >> 2, qt = v & 3;
        for (int idx = tid; idx < 1408; idx += 512) {
            if (idx < 704) { const int bb = lu >> 4, rp = (lu >> 1) & 7, xh = lu & 1, r = 2 * rp;
                ffn_sweep2<true>(U, ACT, cw, cb, NCTX + bb * 1024 + r * 64 + xh * 32, xh * 32, r > 0, r + 2 < 16, 2 * (qt * 704 + idx)); }
            else { const int bb = lu >> 2, sp = lu & 3;
                ffn_sweep2<false>(U, ACT, cw, cb, bb * 256 + sp * 64, sp * 64, true, true, 2 * (qt * 704 + idx - 704)); }
        }
    }
}

#define XB_TMO      128
#define XB_XCNT(j)  (256  + 64 * (j))
#define XB_XSUB(j)  (1280 + 64 * (j))
#define XB_XGEN(j)  (2304 + 64 * (j))
#define XB_TOP      3328
#define XB_TOPGEN   3392
#define XCD_BAR_WORDS 3456
#define XB_SPIN_CAP (1u << 18)
__device__ __forceinline__ unsigned xb_ld(unsigned* p)              { return __hip_atomic_load(p, __ATOMIC_RELAXED, __HIP_MEMORY_SCOPE_AGENT); }
__device__ __forceinline__ unsigned xb_add(unsigned* p, unsigned v) { return __hip_atomic_fetch_add(p, v, __ATOMIC_RELAXED, __HIP_MEMORY_SCOPE_AGENT); }
__device__ __forceinline__ unsigned xb_xcc_id() { return (unsigned)__builtin_amdgcn_s_getreg((3 << 11) | 20) & 0xFu; }
#define XB_SPIN(cond, bar) do { unsigned _sp = 0; while (cond) { __builtin_amdgcn_s_sleep(1); \
    if ((++_sp & 255u) == 0u) { if (xb_ld(&(bar)[XB_TMO])) break; if (_sp > XB_SPIN_CAP) { atomicAdd(&(bar)[XB_TMO], 1u); break; } } } } while (0)
struct XcdBarrier { unsigned* bar; unsigned x; volatile LAS unsigned* st; };
__device__ __forceinline__ XcdBarrier xcd_barrier_post(unsigned* bar, volatile LAS unsigned* st) {
    XcdBarrier b; b.bar = bar; b.x = xb_xcc_id(); b.st = st;
    if (threadIdx.x == 0) (void)xb_add(&bar[XB_XCNT(b.x)], 1u);
    return b;
}
__device__ __forceinline__ void xcd_barrier_complete(unsigned* bar, unsigned x, unsigned& nloc, unsigned& nx) {
    const unsigned G = gridDim.x * gridDim.y * gridDim.z;
    unsigned sum, cnt, mine, sp = 0u;
    for (;;) {
        sum = 0u; cnt = 0u; mine = 0u;
#pragma unroll
        for (unsigned j = 0; j < 16; ++j) { const unsigned c = xb_ld(&bar[XB_XCNT(j)]); sum += c; cnt += (c > 0u) ? 1u : 0u; mine = (j == x) ? c : mine; }
        if (sum == G) break;
        __builtin_amdgcn_s_sleep(1);
        if ((++sp & 255u) == 0u) { if (xb_ld(&bar[XB_TMO])) break; if (sp > XB_SPIN_CAP) { atomicAdd(&bar[XB_TMO], 1u); break; } }
    }
    nloc = mine > 0u ? mine : 1u; nx = cnt > 0u ? cnt : 1u;
}
__device__ __forceinline__ void xcd_barrier(const XcdBarrier& b) {
    asm volatile("s_waitcnt vmcnt(0)" ::: "memory");
    __syncthreads();
    if (threadIdx.x == 0) {
        unsigned* bar = b.bar;
        __builtin_amdgcn_s_waitcnt(0);
        unsigned nloc = b.st[0], nx = b.st[1];
        if (nloc == 0u) { xcd_barrier_complete(bar, b.x, nloc, nx); b.st[0] = nloc; b.st[1] = nx; }
        const unsigned old = xb_add(&bar[XB_XSUB(b.x)], 1u);
        const unsigned gen = old / nloc;
        if (old + 1u == (gen + 1u) * nloc) {
            __builtin_amdgcn_fence(__ATOMIC_RELEASE, "agent");
            asm volatile("s_waitcnt vmcnt(0)" ::: "memory");
            const unsigned og = xb_add(&bar[XB_TOP], 1u);
            const unsigned tg = og / nx;
            if (og + 1u == (tg + 1u) * nx) xb_add(&bar[XB_TOPGEN], 1u);
            else XB_SPIN(xb_ld(&bar[XB_TOPGEN]) == tg, bar);
            __builtin_amdgcn_fence(__ATOMIC_ACQUIRE, "agent");
            xb_add(&bar[XB_XGEN(b.x)], 1u);
            asm volatile("s_waitcnt vmcnt(0)" ::: "memory");
        } else {
            XB_SPIN(xb_ld(&bar[XB_XGEN(b.x)]) == gen, bar);
            __builtin_amdgcn_fence(__ATOMIC_ACQUIRE, "agent");
            asm volatile("s_waitcnt vmcnt(0)" ::: "memory");
        }
    }
    __syncthreads();
}

__device__ __forceinline__ void run_phase(PP P, int ph, LAS unsigned char* lds) {
    using namespace pg8;
#ifndef PMASK
#define PMASK 0xFFF
#endif
    if (ph == 0) { if (PMASK & 1) phase_prologue(P, lds); return; }
    if (ph == 1) { if (PMASK & 2) { prenorm_rows(P); filter_units(P, lds); } return; }
    const int l = (ph - 2) / 10, sp = (ph - 2) % 10;
    StaticOrder S;
    if (!((PMASK >> (2 + sp)) & 1)) return;
    switch (sp) {
    case 0: {
        Gemm g{(const bf16_t*)(P->ws + WS_HB), (const bf16_t*)(P->ws + WS_WIN + l * SZ_WIN), NTOK, NPROJ, D};
        S.init(NTOK, NPROJ, gridDim.x, BID(), 20, 32);
        Epi<EP_PROJ> E{(bf16_t*)(P->ws + WS_A), NPROJ, nullptr, nullptr, nullptr, (bf16_t*)(P->ws + WS_B)};
        gemm_phase(lds, g, S, E); break; }
    case 1: phase_mixers(P, l, lds); break;
    case 2: phase_combine(P, l); break;
    case 3: {
        Gemm ga{(const bf16_t*)(P->ws + WS_OA), (const bf16_t*)(P->ws + WS_WA + l * SZ_WBR), NTOK, D, DA};
        S.init(NTOK, D, gridDim.x, BID(), 0, 0);
        Epi<EP_BRA> Ea{(bf16_t*)(P->ws + WS_D), D, nullptr, (const bf16_t*)(P->ws + WS_A) + 8192, nullptr, nullptr};
        gemm_phase(lds, ga, S, Ea);
        Gemm gb{(const bf16_t*)(P->ws + WS_OB), (const bf16_t*)(P->ws + WS_WB + l * SZ_WBR), NTOK, D, DA};
        Epi<EP_BRB> Eb{(bf16_t*)(P->ws + WS_D + (size_t)NTOK * D * 2), D, nullptr, (const bf16_t*)(P->ws + WS_A) + 10240, (const bf16_t*)(P->ws + WS_D), nullptr};
        gemm_phase(lds, gb, S, Eb); break; }
    case 4: {
        Gemm g{(const bf16_t*)(P->ws + WS_D + (size_t)NTOK * D * 2), (const bf16_t*)(P->ws + WS_WOUT + l * SZ_WOUT), NTOK, D, D};
        S.init(NTOK, D, gridDim.x, BID(), 0, 0);
        Epi<EP_BF16> E{(bf16_t*)(P->ws + WS_B), D, nullptr, nullptr, nullptr, nullptr};
        gemm_phase(lds, g, S, E); break; }
    case 5: row_phase(P, l, (const bf16_t*)(P->ws + WS_B), 0); break;
    case 6: {
        Gemm g{(const bf16_t*)(P->ws + WS_HB), (const bf16_t*)(P->ws + WS_WUP + l * SZ_WUP), NTOK, NUP, D};
        S.init(NTOK, NUP, gridDim.x, BID(), 0, 0);
        Epi<EP_BF16> E{(bf16_t*)(P->ws + WS_A), NUP, nullptr, nullptr, nullptr, nullptr};
        gemm_phase(lds, g, S, E); break; }
    case 7: phase_ffnconv(P, l); break;
    case 8: {
        Gemm g{(const bf16_t*)(P->ws + WS_B), (const bf16_t*)(P->ws + WS_WDN + l * SZ_WDN), NTOK, D, DFF};
        S.init(NTOK, D, gridDim.x, BID(), 0, 0);
        Epi<EP_BF16> E{(bf16_t*)(P->ws + WS_D), D, nullptr, nullptr, nullptr, nullptr};
        gemm_phase(lds, g, S, E); break; }
    case 9: row_phase(P, l, (const bf16_t*)(P->ws + WS_D), 1); break;
    }
}

__global__ void __launch_bounds__(512, 2) fwd_kernel(Params Pv) {
    extern __shared__ __attribute__((aligned(16))) unsigned char shm[];
    PP P = (PP)__builtin_amdgcn_kernarg_segment_ptr();
    LAS unsigned char* lds = (LAS unsigned char*)shm;
    cg::grid_group grid = cg::this_grid();
    if (threadIdx.x < 4) ((LAS unsigned*)(lds + 131072))[threadIdx.x] = 0u;
    __syncthreads();
    (void)xcd_barrier_post((unsigned*)(P->ws + WS_BAR), (volatile LAS unsigned*)(lds + 131072));
#define PHASE_STEP(ph) do { if ((ph) >= P->ph_lo && (ph) < P->ph_hi) { \
        if ((ph) > P->ph_lo) { if (P->ph_hi > NPHASE) grid.sync(); else { XcdBarrier xb; xb.bar = (unsigned*)(P->ws + WS_BAR); xb.x = xb_xcc_id(); xb.st = (volatile LAS unsigned*)(lds + 131072); xcd_barrier(xb); } } \
        run_phase(P, (ph), lds); } } while (0)
    PHASE_STEP(0); PHASE_STEP(1); PHASE_STEP(2); PHASE_STEP(3); PHASE_STEP(4); PHASE_STEP(5); PHASE_STEP(6); PHASE_STEP(7); PHASE_STEP(8); PHASE_STEP(9); PHASE_STEP(10);
    PHASE_STEP(11); PHASE_STEP(12); PHASE_STEP(13); PHASE_STEP(14); PHASE_STEP(15); PHASE_STEP(16); PHASE_STEP(17); PHASE_STEP(18); PHASE_STEP(19); PHASE_STEP(20); PHASE_STEP(21);
#undef PHASE_STEP
}

extern "C" void kernel_launch(void* const* d_in, const int* in_sizes, int n_in, void* d_out, int out_size, void* d_ws, size_t ws_size, hipStream_t stream) {
    static int grid = 0;
    if (grid == 0) {
        if (n_in != 30 || ws_size < WS_END) { fprintf(stderr, "kernel_launch: expected 30 inputs and >= %zu bytes of workspace; got %d, %zu\n", (size_t)WS_END, n_in, ws_size); grid = -1; return; }
        int dev = 0, cus = 0, per_cu = 0;
        hipGetDevice(&dev); hipDeviceGetAttribute(&cus, hipDeviceAttributeMultiprocessorCount, dev);
        if (hipFuncSetAttribute((const void*)fwd_kernel, hipFuncAttributeMaxDynamicSharedMemorySize, LDS_BYTES) != hipSuccess) { fprintf(stderr, "kernel_launch: hipFuncSetAttribute failed\n"); grid = -1; return; }
        hipOccupancyMaxActiveBlocksPerMultiprocessor(&per_cu, (const void*)fwd_kernel, 512, LDS_BYTES);
        if (per_cu < 1) { fprintf(stderr, "kernel_launch: occupancy query reports %d blocks per CU\n", per_cu); per_cu = 1; }
        (void)hipGetLastError();
        grid = cus;
    }
    if (grid < 0) return;
    Params p{};
    for (int i = 0; i < 30; ++i) p.in[i] = (const float*)d_in[i];
    p.out = (float*)d_out; p.ws = (unsigned char*)d_ws;
    if (hipMemsetAsync((char*)d_ws + WS_BAR, 0, 16384, stream) != hipSuccess) { fprintf(stderr, "kernel_launch: memset of the barrier words failed\n"); return; }
#if PER_PHASE_LAUNCH
    for (int ph = 0; ph < NPHASE; ++ph) {
        p.ph_lo = ph; p.ph_hi = ph + 1;
        hipLaunchKernelGGL(fwd_kernel, dim3(grid), dim3(512), LDS_BYTES, stream, p);
    }
#else
    p.ph_lo = 0; p.ph_hi = NPHASE;
    void* args[] = {&p};
    hipError_t e = hipLaunchCooperativeKernel((const void*)fwd_kernel, dim3(grid), dim3(512), args, LDS_BYTES, stream);
    if (e != hipSuccess) fprintf(stderr, "cooperative launch failed: %s (grid %d)\n", hipGetErrorString(e), grid);
#endif
}
```
